# Optimizing an MI355X kernel written in HIP

```python
import jax, jax.numpy as jnp
from jax import lax
import numpy as np

D_MODEL = 1024
BATCH = 16
SEQ = 2048
DEPTH = 2
DEC_BATCH = 128
DEC_SEQ = 8
PAST_LEN = 16384
PAGE_SIZE = 128

N_HEADS = 8
N_KV_HEADS = 2
HEAD_DIM = 64
GQA_GROUP = N_HEADS // N_KV_HEADS
ATTN_WIDTH = N_HEADS * HEAD_DIM
KV_WIDTH = N_KV_HEADS * HEAD_DIM
POOL_WINDOWS = (2, 4, 8, 16)
POOL_WIDTH = D_MODEL - ATTN_WIDTH
POOL_GROUP = POOL_WIDTH // len(POOL_WINDOWS)
POOL_HIST = max(POOL_WINDOWS) - 1
MIX_WIDTH = ATTN_WIDTH + POOL_WIDTH
IN_WIDTH = ATTN_WIDTH + 2 * KV_WIDTH + POOL_WIDTH
WINDOW = 128
BLOCK = WINDOW
ROT_DIM = HEAD_DIM // 4
ROPE_THETA = 500000.0
D_FF = 4 * D_MODEL
N_META = 16
RMS_EPS = 1e-5

kernel_name = "hymba_pool_swa_sink_hybrid_step"


def _rmsnorm(x, g):
    xf = x.astype(jnp.float32)
    r = lax.rsqrt(jnp.mean(xf * xf, axis=-1, keepdims=True) + RMS_EPS)
    return (xf * r * g.astype(jnp.float32)).astype(x.dtype)


def _project(h, g, w):
    xn = _rmsnorm(h, g)
    p = jnp.einsum('btd,de->bte', xn, w)
    b, t = h.shape[0], h.shape[1]
    q = p[..., :ATTN_WIDTH].reshape(b, t, N_HEADS, HEAD_DIM)
    k = p[..., ATTN_WIDTH:ATTN_WIDTH + KV_WIDTH].reshape(b, t, N_KV_HEADS, HEAD_DIM)
    v = p[..., ATTN_WIDTH + KV_WIDTH:ATTN_WIDTH + 2 * KV_WIDTH].reshape(b, t, N_KV_HEADS, HEAD_DIM)
    u = p[..., ATTN_WIDTH + 2 * KV_WIDTH:]
    return q, k, v, u


def _rope(x, pos):
    inv_freq = ROPE_THETA ** (-jnp.arange(0, ROT_DIM, 2, dtype=jnp.float32) / ROT_DIM)
    ang = pos.astype(jnp.float32)[:, None] * inv_freq[None, :]
    cos = jnp.cos(ang)[None, :, None, :]
    sin = jnp.sin(ang)[None, :, None, :]
    xr = x[..., :ROT_DIM].astype(jnp.float32)
    x1, x2 = xr[..., :ROT_DIM // 2], xr[..., ROT_DIM // 2:]
    rot = jnp.concatenate([x1 * cos - x2 * sin, x2 * cos + x1 * sin], axis=-1)
    return jnp.concatenate([rot.astype(x.dtype), x[..., ROT_DIM:]], axis=-1)


def _band_attention(q, k, v, qpos, kpos, sink):
    scale = HEAD_DIM ** -0.5
    s = jnp.einsum('bnqkgd,bnskd->bnkgqs', q, k).astype(jnp.float32) * scale
    dpos = qpos[:, :, None] - kpos[:, None, :]
    mask = (kpos[:, None, :] >= 0) & (dpos >= 0) & (dpos <= WINDOW)
    s = jnp.where(mask[None, :, None, None], s, -jnp.inf)
    sk = sink.astype(jnp.float32).reshape(N_KV_HEADS, GQA_GROUP)[None, None, :, :, None, None]
    m = jnp.maximum(jnp.max(s, axis=-1, keepdims=True), sk)
    p = jnp.exp(s - m)
    denom = jnp.sum(p, axis=-1, keepdims=True) + jnp.exp(sk - m)
    return jnp.einsum('bnkgqs,bnskd->bnqkgd', (p / denom).astype(v.dtype), v)


def _prompt_attention(q, k, v, sink):
    b, L = q.shape[0], q.shape[1]
    padf = BLOCK - N_META
    lp = L + padf
    nb = lp // BLOCK
    pad = lambda a: jnp.pad(a, ((0, 0), (padf, 0)) + ((0, 0),) * (a.ndim - 2))
    qb = pad(q).reshape(b, nb, BLOCK, N_KV_HEADS, GQA_GROUP, HEAD_DIM)
    kb = pad(k).reshape(b, nb, BLOCK, N_KV_HEADS, HEAD_DIM)
    vb = pad(v).reshape(b, nb, BLOCK, N_KV_HEADS, HEAD_DIM)
    shift = lambda a: jnp.concatenate([jnp.zeros_like(a[:, :1]), a[:, :-1]], axis=1)
    kk = jnp.concatenate([shift(kb), kb], axis=2)
    vv = jnp.concatenate([shift(vb), vb], axis=2)
    posb = (jnp.arange(lp) - padf).reshape(nb, BLOCK)
    kpos = jnp.concatenate([posb - BLOCK, posb], axis=1)
    o = _band_attention(qb, kk, vv, posb, kpos, sink)
    return o.reshape(b, lp, ATTN_WIDTH)[:, padf:]


def _sample_attention(q, k, v, ck, cv, sink):
    b, s = q.shape[0], q.shape[1]
    qb = q.reshape(b, 1, s, N_KV_HEADS, GQA_GROUP, HEAD_DIM)
    kk = jnp.concatenate([ck, k], axis=1)[:, None]
    vv = jnp.concatenate([cv, v], axis=1)[:, None]
    qpos = (PAST_LEN + jnp.arange(s))[None]
    kpos = (PAST_LEN - WINDOW + jnp.arange(WINDOW + s))[None]
    o = _band_attention(qb, kk, vv, qpos, kpos, sink)
    return o.reshape(b, s, ATTN_WIDTH)


def _pool_mix(u_all, pos_all, n_out, pool_w, pool_scale):
    T = u_all.shape[1]
    uf = u_all.astype(jnp.float32)
    cs = jnp.cumsum(uf, axis=1)
    cs0 = jnp.concatenate([jnp.zeros_like(cs[:, :1]), cs], axis=1)
    t_idx = jnp.arange(T - n_out, T)
    outs = []
    for g, w in enumerate(POOL_WINDOWS):
        lo_c, hi_c = g * POOL_GROUP, (g + 1) * POOL_GROUP
        lo = jnp.maximum(t_idx + 1 - w, 0)
        wsum = cs0[:, t_idx + 1, lo_c:hi_c] - cs0[:, lo, lo_c:hi_c]
        cnt = jnp.minimum(pos_all[t_idx] + 1, w).astype(jnp.float32)
        d = wsum / cnt[None, :, None] - uf[:, t_idx, lo_c:hi_c]
        outs.append(jnp.einsum('btc,ce->bte', d, pool_w[g].astype(jnp.float32)))
    out = jnp.concatenate(outs, axis=-1) * pool_scale.astype(jnp.float32)
    return out.astype(u_all.dtype)


def _mlp(h, g, w_up, w_down):
    xn = _rmsnorm(h, g)
    a = jax.nn.relu(jnp.einsum('btd,df->btf', xn, w_up))
    return jnp.einsum('btf,fd->btd', a * a, w_down)


def setup_inputs(seed: int = 0) -> dict:
    key = jax.random.key(seed)
    ks = jax.random.split(key, 17)
    n = lambda k, s, sc=1.0: jax.random.normal(k, s, jnp.float32) * sc
    return {
        "x_prompt": n(ks[0], (BATCH, SEQ, D_MODEL)),
        "x_sample": n(ks[1], (DEC_BATCH, DEC_SEQ, D_MODEL)),
        "cache_k": n(ks[2], (DEPTH, DEC_BATCH, WINDOW, N_KV_HEADS, HEAD_DIM)),
        "cache_v": n(ks[3], (DEPTH, DEC_BATCH, WINDOW, N_KV_HEADS, HEAD_DIM)),
        "state_pool": n(ks[4], (DEPTH, DEC_BATCH, POOL_HIST, POOL_WIDTH)),
        "meta_tokens": n(ks[5], (N_META, D_MODEL)),
        "ln1": 1.0 + n(ks[6], (DEPTH, D_MODEL), 0.02),
        "w_in": n(ks[7], (DEPTH, D_MODEL, IN_WIDTH), D_MODEL ** -0.5),
        "attn_sinks": n(ks[8], (DEPTH, N_HEADS), 0.5),
        "pool_w": n(ks[9], (DEPTH, len(POOL_WINDOWS), POOL_GROUP, POOL_GROUP), POOL_GROUP ** -0.5),
        "pool_scale": 1.0 + n(ks[10], (DEPTH, POOL_WIDTH), 0.1),
        "w_out": n(ks[11], (DEPTH, MIX_WIDTH, D_MODEL), MIX_WIDTH ** -0.5),
        "ln2": 1.0 + n(ks[12], (DEPTH, D_MODEL), 0.02),
        "w_up": n(ks[13], (DEPTH, D_MODEL, D_FF), D_MODEL ** -0.5),
        "w_down": n(ks[14], (DEPTH, D_FF, D_MODEL), D_FF ** -0.5),
        "ln_f": 1.0 + n(ks[15], (D_MODEL,), 0.02),
    }


def reference(x_prompt, x_sample, cache_k, cache_v, state_pool, meta_tokens, ln1, w_in, attn_sinks,
              pool_w, pool_scale, w_out, ln2, w_up, w_down, ln_f):
    b = x_prompt.shape[0]
    meta = jnp.broadcast_to(meta_tokens.astype(x_prompt.dtype)[None], (b, N_META, D_MODEL))
    hp = jnp.concatenate([meta, x_prompt], axis=1)
    L = hp.shape[1]
    pos_p = jnp.arange(L)
    hs = x_sample
    s = x_sample.shape[1]
    pos_s = PAST_LEN + jnp.arange(s)
    pos_pool_s = PAST_LEN - POOL_HIST + jnp.arange(POOL_HIST + s)
    pk, pv, pu, sk, sv, su = [], [], [], [], [], []
    for l in range(DEPTH):
        q, k, v, u = _project(hp, ln1[l], w_in[l])
        q = _rope(q, pos_p)
        k = _rope(k, pos_p)
        a = _prompt_attention(q, k, v, attn_sinks[l])
        pm = _pool_mix(u, pos_p, L, pool_w[l], pool_scale[l])
        hp = hp + jnp.einsum('bte,ed->btd', jnp.concatenate([a, pm], axis=-1), w_out[l])
        hp = hp + _mlp(hp, ln2[l], w_up[l], w_down[l])
        pk.append(k[:, -WINDOW:])
        pv.append(v[:, -WINDOW:])
        pu.append(u[:, -POOL_HIST:])
        q, k, v, u = _project(hs, ln1[l], w_in[l])
        q = _rope(q, pos_s)
        k = _rope(k, pos_s)
        a = _sample_attention(q, k, v, cache_k[l], cache_v[l], attn_sinks[l])
        u_all = jnp.concatenate([state_pool[l].astype(u.dtype), u], axis=1)
        pm = _pool_mix(u_all, pos_pool_s, s, pool_w[l], pool_scale[l])
        hs = hs + jnp.einsum('bte,ed->btd', jnp.concatenate([a, pm], axis=-1), w_out[l])
        hs = hs + _mlp(hs, ln2[l], w_up[l], w_down[l])
        sk.append(jnp.concatenate([cache_k[l].astype(k.dtype), k], axis=1)[:, -WINDOW:])
        sv.append(jnp.concatenate([cache_v[l].astype(v.dtype), v], axis=1)[:, -WINDOW:])
        su.append(u_all[:, -POOL_HIST:])
    y_prompt = _rmsnorm(hp, ln_f)[:, N_META:]
    y_sample = _rmsnorm(hs, ln_f)
    return (y_prompt, y_sample, jnp.stack(pk), jnp.stack(pv), jnp.stack(pu), jnp.stack(sk), jnp.stack(sv), jnp.stack(su))
```

```cpp
#include <hip/hip_runtime.h>
#include <hip/hip_cooperative_groups.h>
#include <cstdio>
#include <cstdint>
namespace cg = cooperative_groups;

typedef unsigned short bf16_t;
typedef short bf16x8 __attribute__((ext_vector_type(8)));
typedef float f32x4 __attribute__((ext_vector_type(4)));
typedef unsigned u32x4 __attribute__((ext_vector_type(4)));
typedef unsigned u32x2 __attribute__((ext_vector_type(2)));
#define DEVI __device__ __forceinline__

constexpr int DM = 1024, LP = 2064, NBATCH = 16, MP = NBATCH * LP  , DB = 128, DS = 8, MS = DB * DS  ;
constexpr int MT = MP + MS  , INW = 1280, DFF = 4096, NM = MT / 128  ;
constexpr int NROPE = LP + DS;
constexpr float EPS = 1e-5f;

constexpr size_t O_YP = 0;
constexpr size_t O_YS = O_YP + (size_t)16 * 2048 * 1024;
constexpr size_t O_NKP = O_YS + (size_t)128 * 8 * 1024;
constexpr size_t O_NVP = O_NKP + (size_t)2 * 16 * 128 * 128;
constexpr size_t O_NPP = O_NVP + (size_t)2 * 16 * 128 * 128;
constexpr size_t O_NKS = O_NPP + (size_t)2 * 16 * 15 * 512;
constexpr size_t O_NVS = O_NKS + (size_t)2 * 128 * 128 * 128;
constexpr size_t O_NPS = O_NVS + (size_t)2 * 128 * 128 * 128;
constexpr size_t O_END = O_NPS + (size_t)2 * 128 * 15 * 512;

constexpr size_t WIN_E = (size_t)INW * DM, WOUT_E = (size_t)DM * DM, WUP_E = (size_t)DFF * DM, WDN_E = (size_t)DM * DFF;
constexpr size_t WL_E = WIN_E + WOUT_E + WUP_E + WDN_E;
constexpr size_t OFF_W = 0;
constexpr size_t OFF_H = OFF_W + 2 * WL_E * 2;
constexpr size_t OFF_HB = OFF_H + (size_t)MT * DM * 4;
constexpr size_t OFF_RS = OFF_HB + (size_t)MT * DM * 2;
constexpr size_t OFF_ROPE = OFF_RS + (size_t)MT * 16 * 4;
constexpr size_t OFF_OV = OFF_ROPE + (size_t)NROPE * 16 * 4;
constexpr size_t OV_Q = 0;
constexpr size_t OV_K = OV_Q + (size_t)MT * 512 * 2;
constexpr size_t OV_V = OV_K + (size_t)MT * 128 * 2;
constexpr size_t OV_U = OV_V + (size_t)MT * 128 * 2;
constexpr size_t OV_MIX = OV_U + (size_t)MT * 512 * 2;
constexpr size_t OV_END = OV_MIX + (size_t)MT * 1024 * 2;
constexpr size_t WS_NEED = OFF_OV + (size_t)MT * DFF * 2;
static_assert(OV_END <= (size_t)MT * DFF * 2, "overlay");

constexpr int LDS_BYTES = 44544;

struct Params {
    const float *x_prompt, *x_sample, *cache_k, *cache_v, *state_pool, *meta, *ln1, *w_in, *sinks, *pool_w, *pool_scale, *w_out, *ln2, *w_up, *w_down, *ln_f;
    float* out;
    unsigned char* ws;
};

DEVI unsigned pk_bf16(float lo, float hi) { unsigned r; asm("v_cvt_pk_bf16_f32 %0, %1, %2" : "=v"(r) : "v"(lo), "v"(hi)); return r; }
DEVI float bf_lo(unsigned w) { return __uint_as_float(w << 16); }
DEVI float bf_hi(unsigned w) { return __uint_as_float(w & 0xffff0000u); }
DEVI u32x2 pk4(f32x4 v) { u32x2 r; r.x = pk_bf16(v[0], v[1]); r.y = pk_bf16(v[2], v[3]); return r; }

template <class Epi>
DEVI void gemm_phase(const bf16_t* __restrict__ A, const bf16_t* __restrict__ Bt, const int nM, const int nN, const int K, const Epi& epi, unsigned char* lds) {
    const int ntiles = nM * nN;
    const int tid = threadIdx.x, lane = tid & 63, wid = tid >> 6, wr = wid >> 1, wc = wid & 1, fr = lane & 15, fq = lane >> 4;
    const int srow = tid >> 3, skc = tid & 7;
    const int nt = K >> 6;
    unsigned char* ldsA = lds;
    unsigned char* ldsB = lds + 128 * 144;
    for (int T = blockIdx.x; T < ntiles; T += gridDim.x) {
        int L;
        { const int q = ntiles >> 3, r = ntiles & 7, x = T & 7, off = T >> 3; L = (x < r ? x * (q + 1) : r * (q + 1) + (x - r) * q) + off; }
        const int nig = 8 * nN, gid = L / nig, fm = gid * 8, gsz = (nM - fm) < 8 ? (nM - fm) : 8;
        const int win = L - gid * nig;
        const int pm = fm + win % gsz, pn = win / gsz;
        const bf16_t* Ap = A + (size_t)(pm * 128 + srow) * K + skc * 8;
        const bf16_t* Bp = Bt + (size_t)(pn * 128 + srow) * K + skc * 8;
        f32x4 acc[4][4];
#pragma unroll
        for (int i = 0; i < 4; ++i)
#pragma unroll
            for (int j = 0; j < 4; ++j) acc[i][j] = (f32x4){0.f, 0.f, 0.f, 0.f};
        u32x4 ra[4], rb[4];
#pragma unroll
        for (int i = 0; i < 4; ++i) { ra[i] = *(const u32x4*)(Ap + (size_t)i * 32 * K); rb[i] = *(const u32x4*)(Bp + (size_t)i * 32 * K); }
        for (int kt = 0; kt < nt; ++kt) {
            __syncthreads();
#pragma unroll
            for (int i = 0; i < 4; ++i) {
                *(u32x4*)(ldsA + (srow + 32 * i) * 144 + skc * 16) = ra[i];
                *(u32x4*)(ldsB + (srow + 32 * i) * 144 + skc * 16) = rb[i];
            }
            __syncthreads();
            if (kt + 1 < nt) {
                const int k0 = (kt + 1) << 6;
#pragma unroll
                for (int i = 0; i < 4; ++i) { ra[i] = *(const u32x4*)(Ap + (size_t)i * 32 * K + k0); rb[i] = *(const u32x4*)(Bp + (size_t)i * 32 * K + k0); }
            }
#pragma unroll
            for (int ks = 0; ks < 2; ++ks) {
                bf16x8 af[4], bfr[4];
#pragma unroll
                for (int i = 0; i < 4; ++i) af[i] = *(const bf16x8*)(ldsA + (wr * 64 + i * 16 + fr) * 144 + ks * 64 + fq * 16);
#pragma unroll
                for (int j = 0; j < 4; ++j) bfr[j] = *(const bf16x8*)(ldsB + (wc * 64 + j * 16 + fr) * 144 + ks * 64 + fq * 16);
#pragma unroll
                for (int i = 0; i < 4; ++i)
#pragma unroll
                    for (int j = 0; j < 4; ++j) acc[i][j] = __builtin_amdgcn_mfma_f32_16x16x32_bf16(bfr[j], af[i], acc[i][j], 0, 0, 0);
            }
        }
        epi(acc, pm, pn, wr, wc, fr, fq);
    }
}

DEVI float row_rs(const float* rowss, int row) {
    const f32x4* rp = (const f32x4*)(rowss + (size_t)row * 16);
    const f32x4 a = (rp[0] + rp[1]) + (rp[2] + rp[3]);
    const float ss = (a[0] + a[1]) + (a[2] + a[3]);
    return rsqrtf(ss * (1.f / 1024.f) + EPS);
}

struct EpiIn {
    const float* rowss; const float* rope; bf16_t *Q, *Kb, *Vb, *U; float* out; int l;
    DEVI void operator()(const f32x4 (&acc)[4][4], int pm, int pn, int wr, int wc, int fr, int fq) const {
        const int cb = pn * 128 + wc * 64;
#pragma unroll
        for (int i = 0; i < 4; ++i) {
            const int row = pm * 128 + wr * 64 + i * 16 + fr;
            const float rs = row_rs(rowss, row);
            const bool samp = row >= MP;
            int b, t;
            if (!samp) { b = row / LP; t = row - b * LP; } else { const int r = row - MP; b = r >> 3; t = r & 7; }
            f32x4 v[4];
#pragma unroll
            for (int j = 0; j < 4; ++j) v[j] = acc[i][j] * rs;
            if (cb < 640) {
                const int pidx = samp ? LP + t : t;
                const f32x4 cs = *(const f32x4*)(rope + pidx * 16 + 4 * (fq & 1));
                const f32x4 sn = *(const f32x4*)(rope + pidx * 16 + 8 + 4 * (fq & 1));
                f32x4 pr;
#pragma unroll
                for (int jj = 0; jj < 4; ++jj) pr[jj] = __shfl_xor(v[0][jj], 32);
                const float sg = fq < 2 ? -1.f : 1.f;
                v[0] = v[0] * cs + pr * sn * sg;
            }
            if (cb < 512) {
#pragma unroll
                for (int j = 0; j < 4; ++j) *(u32x2*)(Q + (size_t)row * 512 + cb + j * 16 + 4 * fq) = pk4(v[j] * 0.125f);
            } else if (cb < 768) {
                const bool isk = cb < 640;
                const int kc = isk ? cb - 512 : cb - 640;
                bf16_t* dstb = (isk ? Kb : Vb) + (size_t)row * 128 + kc + 4 * fq;
#pragma unroll
                for (int j = 0; j < 4; ++j) *(u32x2*)(dstb + j * 16) = pk4(v[j]);
                float* dst = nullptr;
                if (!samp) { if (t >= LP - 128) dst = out + (isk ? O_NKP : O_NVP) + ((size_t)((l * 16 + b) * 128 + (t - (LP - 128)))) * 128; }
                else dst = out + (isk ? O_NKS : O_NVS) + ((size_t)((l * 128 + b) * 128 + 120 + t)) * 128;
                if (dst) {
#pragma unroll
                    for (int j = 0; j < 4; ++j) *(f32x4*)(dst + kc + j * 16 + 4 * fq) = v[j];
                }
            } else {
                const int uc = cb - 768;
                bf16_t* dstb = U + (size_t)row * 512 + uc + 4 * fq;
#pragma unroll
                for (int j = 0; j < 4; ++j) *(u32x2*)(dstb + j * 16) = pk4(v[j]);
                float* dst = nullptr;
                if (!samp) { if (t >= LP - 15) dst = out + O_NPP + ((size_t)((l * 16 + b) * 15 + (t - (LP - 15)))) * 512; }
                else dst = out + O_NPS + ((size_t)((l * 128 + b) * 15 + 7 + t)) * 512;
                if (dst) {
#pragma unroll
                    for (int j = 0; j < 4; ++j) *(f32x4*)(dst + uc + j * 16 + 4 * fq) = v[j];
                }
            }
        }
    }
};

struct EpiRes {
    float* H; bf16_t* Hb; float* rowss;
    DEVI void operator()(const f32x4 (&acc)[4][4], int pm, int pn, int wr, int wc, int fr, int fq) const {
#pragma unroll
        for (int i = 0; i < 4; ++i) {
            const int row = pm * 128 + wr * 64 + i * 16 + fr;
            float ss = 0.f;
#pragma unroll
            for (int j = 0; j < 4; ++j) {
                const size_t o = (size_t)row * DM + pn * 128 + wc * 64 + j * 16 + 4 * fq;
                f32x4 h = *(const f32x4*)(H + o);
                h = h + acc[i][j];
                *(f32x4*)(H + o) = h;
                *(u32x2*)(Hb + o) = pk4(h);
                ss += (h[0] * h[0] + h[1] * h[1]) + (h[2] * h[2] + h[3] * h[3]);
            }
            ss += __shfl_xor(ss, 16);
            ss += __shfl_xor(ss, 32);
            if (fq == 0) rowss[(size_t)row * 16 + pn * 2 + wc] = ss;
        }
    }
};

struct EpiUp {
    const float* rowss; bf16_t* ACT;
    DEVI void operator()(const f32x4 (&acc)[4][4], int pm, int pn, int wr, int wc, int fr, int fq) const {
#pragma unroll
        for (int i = 0; i < 4; ++i) {
            const int row = pm * 128 + wr * 64 + i * 16 + fr;
            const float rs = row_rs(rowss, row);
#pragma unroll
            for (int j = 0; j < 4; ++j) {
                f32x4 a = acc[i][j] * rs;
#pragma unroll
                for (int e = 0; e < 4; ++e) { const float x = fmaxf(a[e], 0.f); a[e] = x * x; }
                *(u32x2*)(ACT + (size_t)row * DFF + pn * 128 + wc * 64 + j * 16 + 4 * fq) = pk4(a);
            }
        }
    }
};

DEVI void transpose_tile(const float* __restrict__ W, int N, const float* __restrict__ g, bf16_t* __restrict__ Wt, int ldk, int kt, int nt_, unsigned char* lds) {
    float* t = (float*)lds;
    const int tid = threadIdx.x;
    __syncthreads();
    {
        const int ty = tid >> 4, n4 = (tid & 15) * 4;
#pragma unroll
        for (int i = 0; i < 4; ++i) {
            const int k = ty + 16 * i;
            f32x4 v = *(const f32x4*)(W + (size_t)(kt * 64 + k) * N + nt_ * 64 + n4);
            const float s = g ? g[kt * 64 + k] : 1.f;
            t[k * 65 + n4 + 0] = v[0] * s; t[k * 65 + n4 + 1] = v[1] * s; t[k * 65 + n4 + 2] = v[2] * s; t[k * 65 + n4 + 3] = v[3] * s;
        }
    }
    __syncthreads();
    {
        const int n = tid >> 2, kq = (tid & 3) * 16;
        u32x4 o0, o1;
        o0.x = pk_bf16(t[(kq + 0) * 65 + n], t[(kq + 1) * 65 + n]);   o0.y = pk_bf16(t[(kq + 2) * 65 + n], t[(kq + 3) * 65 + n]);
        o0.z = pk_bf16(t[(kq + 4) * 65 + n], t[(kq + 5) * 65 + n]);   o0.w = pk_bf16(t[(kq + 6) * 65 + n], t[(kq + 7) * 65 + n]);
        o1.x = pk_bf16(t[(kq + 8) * 65 + n], t[(kq + 9) * 65 + n]);   o1.y = pk_bf16(t[(kq + 10) * 65 + n], t[(kq + 11) * 65 + n]);
        o1.z = pk_bf16(t[(kq + 12) * 65 + n], t[(kq + 13) * 65 + n]); o1.w = pk_bf16(t[(kq + 14) * 65 + n], t[(kq + 15) * 65 + n]);
        bf16_t* d = Wt + (size_t)(nt_ * 64 + n) * ldk + kt * 64 + kq;
        *(u32x4*)d = o0; *(u32x4*)(d + 8) = o1;
    }
}

DEVI bf16_t* wt_in(unsigned char* ws, int l) { return (bf16_t*)(ws + OFF_W) + (size_t)l * WL_E; }
DEVI bf16_t* wt_out(unsigned char* ws, int l) { return wt_in(ws, l) + WIN_E; }
DEVI bf16_t* wt_up(unsigned char* ws, int l) { return wt_out(ws, l) + WOUT_E; }
DEVI bf16_t* wt_dn(unsigned char* ws, int l) { return wt_up(ws, l) + WUP_E; }

constexpr int U_TRL = 320 + 128 + 1024 + 1024;
constexpr int U_TR = 2 * U_TRL;
constexpr int U_WC = U_TR + 128;
constexpr int U_ROWS = U_WC + MT / 4;
constexpr int U_ROPE = U_ROWS + (NROPE * 8 + 255) / 256;
constexpr int U_CK = U_ROPE + 256;
constexpr int U_CV = U_CK + 256;
constexpr int U_CP = U_CV + 256;

DEVI void prologue(const Params& p, unsigned char* lds) {
    const int tid = threadIdx.x, lane = tid & 63, wid = tid >> 6;
    float* H = (float*)(p.ws + OFF_H);
    bf16_t* Hb = (bf16_t*)(p.ws + OFF_HB);
    float* rowss = (float*)(p.ws + OFF_RS);
    float* rope = (float*)(p.ws + OFF_ROPE);
    for (int u = blockIdx.x; u < U_CP; u += gridDim.x) {
        if (u < U_TR) {
            const int l = u / U_TRL; int r = u - l * U_TRL;
            if (r < 320) { transpose_tile(p.w_in + (size_t)l * DM * INW, INW, p.ln1 + l * DM, wt_in(p.ws, l), DM, r & 15, r >> 4, lds); }
            else if ((r -= 320) < 128) { transpose_tile(p.w_out + (size_t)l * DM * DM, DM, nullptr, wt_out(p.ws, l), DM, r & 7, r >> 3, lds); }
            else if ((r -= 128) < 1024) { transpose_tile(p.w_up + (size_t)l * DM * DFF, DFF, p.ln2 + l * DM, wt_up(p.ws, l), DM, r & 15, r >> 4, lds); }
            else { r -= 1024; transpose_tile(p.w_down + (size_t)l * DFF * DM, DM, nullptr, wt_dn(p.ws, l), DFF, r & 63, r >> 6, lds); }
        } else if (u < U_WC) {
            const int r = u - U_TR, l = r >> 6, g = (r >> 4) & 3, n = (r & 15) * 64 + lane, c0 = wid * 32;
            const float* pw = p.pool_w + ((size_t)(l * 4 + g) * 128 + c0) * 128;
            const float* sc = p.pool_scale + l * 512 + g * 128;
            const float* wo = p.w_out + (size_t)l * DM * DM + (size_t)(512 + g * 128) * DM + n;
            float acc[32];
#pragma unroll
            for (int c = 0; c < 32; ++c) acc[c] = 0.f;
            for (int e = 0; e < 128; ++e) {
                const float w = wo[(size_t)e * DM] * sc[e];
#pragma unroll
                for (int c = 0; c < 32; ++c) acc[c] += pw[c * 128 + e] * w;
            }
            bf16_t* d = wt_out(p.ws, l) + (size_t)n * DM + 512 + g * 128 + c0;
#pragma unroll
            for (int c = 0; c < 32; c += 8) {
                u32x4 o; o.x = pk_bf16(acc[c], acc[c + 1]); o.y = pk_bf16(acc[c + 2], acc[c + 3]); o.z = pk_bf16(acc[c + 4], acc[c + 5]); o.w = pk_bf16(acc[c + 6], acc[c + 7]);
                *(u32x4*)(d + c) = o;
            }
        } else if (u < U_ROWS) {
            const int row = (u - U_WC) * 4 + wid;
            const float* src;
            if (row < MP) { const int b = row / LP, t = row - b * LP; src = t < 16 ? p.meta + (size_t)t * DM : p.x_prompt + ((size_t)b * 2048 + (t - 16)) * DM; }
            else src = p.x_sample + (size_t)(row - MP) * DM;
            float ss = 0.f;
#pragma unroll
            for (int i = 0; i < 4; ++i) {
                const int c = i * 256 + lane * 4;
                const f32x4 v = *(const f32x4*)(src + c);
                *(f32x4*)(H + (size_t)row * DM + c) = v;
                *(u32x2*)(Hb + (size_t)row * DM + c) = pk4(v);
                ss += (v[0] * v[0] + v[1] * v[1]) + (v[2] * v[2] + v[3] * v[3]);
            }
#pragma unroll
            for (int o = 32; o >= 1; o >>= 1) ss += __shfl_xor(ss, o);
            if (lane < 16) rowss[(size_t)row * 16 + lane] = lane == 0 ? ss : 0.f;
        } else if (u < U_ROPE) {
            const int id = (u - U_ROWS) * 256 + tid;
            if (id < NROPE * 8) {
                const int idx = id >> 3, i = id & 7;
                const int pos = idx < LP ? idx : 16384 + (idx - LP);
                const float inv = exp2f(-(float)i * 0.125f * 18.931568569324174f);
                const float ang = (float)pos * inv;
                double rev = (double)ang * 0.15915494309189535;
                rev -= rint(rev);
                const float red = (float)(rev * 6.283185307179586);
                rope[idx * 16 + i] = __cosf(red);
                rope[idx * 16 + 8 + i] = __sinf(red);
            }
        } else if (u < U_CV) {
            const bool isk = u < U_CK;
            const int r = isk ? u - U_ROPE : u - U_CK;
            const f32x4* src = (const f32x4*)((isk ? p.cache_k : p.cache_v) + (size_t)r * 128 * 128 + 8 * 128);
            f32x4* dst = (f32x4*)(p.out + (isk ? O_NKS : O_NVS) + (size_t)r * 128 * 128);
            for (int i = tid; i < 120 * 32; i += 256) dst[i] = src[i];
        } else {
            const int r = u - U_CV;
            const f32x4* src = (const f32x4*)(p.state_pool + (size_t)r * 15 * 512 + 8 * 512);
            f32x4* dst = (f32x4*)(p.out + O_NPS + (size_t)r * 15 * 512);
            for (int i = tid; i < 7 * 128; i += 256) dst[i] = src[i];
        }
    }
}

constexpr int N_PU = NBATCH * 65 * 2;
constexpr int N_AU = N_PU + DB * 2;

DEVI void add8(f32x4& a0, f32x4& a1, const u32x4 w) {
    a0[0] += bf_lo(w.x); a0[1] += bf_hi(w.x); a0[2] += bf_lo(w.y); a0[3] += bf_hi(w.y);
    a1[0] += bf_lo(w.z); a1[1] += bf_hi(w.z); a1[2] += bf_lo(w.w); a1[3] += bf_hi(w.w);
}

DEVI void mixer_phase(const Params& p, const int l, unsigned char* lds) {
    const int tid = threadIdx.x, lane = tid & 63, wid = tid >> 6, fr = lane & 15, fq = lane >> 4;
    const bf16_t* Q = (const bf16_t*)(p.ws + OFF_OV + OV_Q);
    const bf16_t* Kb = (const bf16_t*)(p.ws + OFF_OV + OV_K);
    const bf16_t* Vb = (const bf16_t*)(p.ws + OFF_OV + OV_V);
    const bf16_t* U = (const bf16_t*)(p.ws + OFF_OV + OV_U);
    bf16_t* MIX = (bf16_t*)(p.ws + OFF_OV + OV_MIX);
    unsigned char* Ks = lds;
    bf16_t* Vt = (bf16_t*)(lds + 160 * 144);
    for (int unit = blockIdx.x; unit < N_AU; unit += gridDim.x) {
        const bool samp = unit >= N_PU;
        int b, kvh, t0;
        if (!samp) { kvh = unit & 1; const int r = unit >> 1; b = r / 65; t0 = (r - b * 65) * 32; }
        else { const int r = unit - N_PU; kvh = r & 1; b = r >> 1; t0 = 0; }
        const int rowbase = samp ? MP + b * 8 : b * LP;

        if (!samp) {
#pragma unroll 1
            for (int i = 0; i < 4; ++i) {
                const int c = tid + 256 * i, ir = c >> 5, ch = kvh * 256 + (c & 31) * 8, g = ch >> 7, w = 2 << g, pos = t0 + ir;
                if (pos < LP) {
                    const int n = (pos + 1) < w ? (pos + 1) : w;
                    const bf16_t* up = U + (size_t)(rowbase + pos) * 512 + ch;
                    f32x4 a0 = {0.f, 0.f, 0.f, 0.f}, a1 = {0.f, 0.f, 0.f, 0.f}, u0 = a0, u1 = a0;
                    add8(u0, u1, *(const u32x4*)up);
                    for (int ii = 1; ii < n; ++ii) add8(a0, a1, *(const u32x4*)(up - (size_t)ii * 512));
                    const float inv = 1.f / (float)n;
                    a0 = (a0 + u0) * inv - u0; a1 = (a1 + u1) * inv - u1;
                    u32x4 o; o.x = pk_bf16(a0[0], a0[1]); o.y = pk_bf16(a0[2], a0[3]); o.z = pk_bf16(a1[0], a1[1]); o.w = pk_bf16(a1[2], a1[3]);
                    *(u32x4*)(MIX + (size_t)(rowbase + pos) * 1024 + 512 + ch) = o;
                }
            }
        } else {
            const int s = tid >> 5, ch = kvh * 256 + (tid & 31) * 8, g = ch >> 7, w = 2 << g;
            f32x4 a0 = {0.f, 0.f, 0.f, 0.f}, a1 = {0.f, 0.f, 0.f, 0.f}, u0 = a0, u1 = a0;
            add8(u0, u1, *(const u32x4*)(U + (size_t)(rowbase + s) * 512 + ch));
            for (int ii = 1; ii < w; ++ii) {
                const int r = s - ii;
                if (r >= 0) add8(a0, a1, *(const u32x4*)(U + (size_t)(rowbase + r) * 512 + ch));
                else { const float* sp = p.state_pool + ((size_t)(l * 128 + b) * 15 + (15 + r)) * 512 + ch; a0 = a0 + *(const f32x4*)sp; a1 = a1 + *(const f32x4*)(sp + 4); }
            }
            const float inv = 1.f / (float)w;
            a0 = (a0 + u0) * inv - u0; a1 = (a1 + u1) * inv - u1;
            u32x4 o; o.x = pk_bf16(a0[0], a0[1]); o.y = pk_bf16(a0[2], a0[3]); o.z = pk_bf16(a1[0], a1[1]); o.w = pk_bf16(a1[2], a1[3]);
            *(u32x4*)(MIX + (size_t)(rowbase + s) * 1024 + 512 + ch) = o;
        }

        u32x4 kq[5], vq[5];
#pragma unroll
        for (int i = 0; i < 5; ++i) {
            const int c = tid + 256 * i, j = c >> 3, dc = c & 7;
            kq[i] = (u32x4){0u, 0u, 0u, 0u}; vq[i] = kq[i];
            if (!samp) {
                const int kpos = t0 - 128 + j;
                if (kpos >= 0 && kpos < LP) {
                    const size_t o = (size_t)(rowbase + kpos) * 128 + kvh * 64 + dc * 8;
                    kq[i] = *(const u32x4*)(Kb + o); vq[i] = *(const u32x4*)(Vb + o);
                }
            } else if (j < 128) {
                const size_t o = (((size_t)(l * 128 + b) * 128 + j) * 2 + kvh) * 64 + dc * 8;
                const f32x4 k0 = *(const f32x4*)(p.cache_k + o), k1 = *(const f32x4*)(p.cache_k + o + 4);
                const f32x4 v0 = *(const f32x4*)(p.cache_v + o), v1 = *(const f32x4*)(p.cache_v + o + 4);
                kq[i].x = pk_bf16(k0[0], k0[1]); kq[i].y = pk_bf16(k0[2], k0[3]); kq[i].z = pk_bf16(k1[0], k1[1]); kq[i].w = pk_bf16(k1[2], k1[3]);
                vq[i].x = pk_bf16(v0[0], v0[1]); vq[i].y = pk_bf16(v0[2], v0[3]); vq[i].z = pk_bf16(v1[0], v1[1]); vq[i].w = pk_bf16(v1[2], v1[3]);
            } else if (j < 136) {
                const size_t o = (size_t)(rowbase + j - 128) * 128 + kvh * 64 + dc * 8;
                kq[i] = *(const u32x4*)(Kb + o); vq[i] = *(const u32x4*)(Vb + o);
            }
        }
        const int h = kvh * 4 + wid;
        bf16x8 qf[2][2];
#pragma unroll
        for (int qt = 0; qt < 2; ++qt) {
            const int i = qt * 16 + fr;
            const bool ok = samp ? (i < 8) : (t0 + i < LP);
            const bf16_t* qp = Q + (size_t)(rowbase + (samp ? 0 : t0) + i) * 512 + h * 64 + fq * 8;
#pragma unroll
            for (int ks = 0; ks < 2; ++ks) {
                u32x4 w = {0u, 0u, 0u, 0u};
                if (ok) w = *(const u32x4*)(qp + ks * 32);
                qf[qt][ks] = __builtin_bit_cast(bf16x8, w);
            }
        }
        __syncthreads();
#pragma unroll
        for (int i = 0; i < 5; ++i) {
            const int c = tid + 256 * i, j = c >> 3, dc = c & 7;
            *(u32x4*)(Ks + j * 144 + dc * 16) = kq[i];
            bf16_t* vt = Vt + (dc * 8) * 168 + j;
            vt[0 * 168] = (bf16_t)(vq[i].x & 0xffff); vt[1 * 168] = (bf16_t)(vq[i].x >> 16);
            vt[2 * 168] = (bf16_t)(vq[i].y & 0xffff); vt[3 * 168] = (bf16_t)(vq[i].y >> 16);
            vt[4 * 168] = (bf16_t)(vq[i].z & 0xffff); vt[5 * 168] = (bf16_t)(vq[i].z >> 16);
            vt[6 * 168] = (bf16_t)(vq[i].w & 0xffff); vt[7 * 168] = (bf16_t)(vq[i].w >> 16);
        }
        __syncthreads();

        f32x4 s[2][10];
#pragma unroll
        for (int t = 0; t < 10; ++t) {
            const bf16x8 k0 = *(const bf16x8*)(Ks + (16 * t + fr) * 144 + fq * 16);
            const bf16x8 k1 = *(const bf16x8*)(Ks + (16 * t + fr) * 144 + 64 + fq * 16);
#pragma unroll
            for (int qt = 0; qt < 2; ++qt) {
                f32x4 z = {0.f, 0.f, 0.f, 0.f};
                z = __builtin_amdgcn_mfma_f32_16x16x32_bf16(k0, qf[qt][0], z, 0, 0, 0);
                s[qt][t] = __builtin_amdgcn_mfma_f32_16x16x32_bf16(k1, qf[qt][1], z, 0, 0, 0);
            }
        }
        const float sink = p.sinks[l * 8 + h];
        float inv[2];
#pragma unroll
        for (int qt = 0; qt < 2; ++qt) {
            const int i = qt * 16 + fr;
            float mx = -INFINITY;
#pragma unroll
            for (int t = 0; t < 10; ++t)
#pragma unroll
                for (int jj = 0; jj < 4; ++jj) {
                    const int j = 16 * t + 4 * fq + jj;
                    const bool ok = (j >= i) && (j <= i + 128) && (samp || (t0 - 128 + j >= 0));
                    const float x = ok ? s[qt][t][jj] : -INFINITY;
                    s[qt][t][jj] = x;
                    mx = fmaxf(mx, x);
                }
            mx = fmaxf(mx, __shfl_xor(mx, 16));
            mx = fmaxf(mx, __shfl_xor(mx, 32));
            const float m = fmaxf(mx, sink);
            float sum = 0.f;
#pragma unroll
            for (int t = 0; t < 10; ++t)
#pragma unroll
                for (int jj = 0; jj < 4; ++jj) { const float e = __expf(s[qt][t][jj] - m); s[qt][t][jj] = e; sum += e; }
            sum += __shfl_xor(sum, 16);
            sum += __shfl_xor(sum, 32);
            inv[qt] = 1.f / (sum + __expf(sink - m));
        }
        f32x4 o[2][4];
#pragma unroll
        for (int qt = 0; qt < 2; ++qt)
#pragma unroll
            for (int dt = 0; dt < 4; ++dt) o[qt][dt] = (f32x4){0.f, 0.f, 0.f, 0.f};
#pragma unroll
        for (int pp = 0; pp < 5; ++pp) {
            bf16x8 pf[2];
#pragma unroll
            for (int qt = 0; qt < 2; ++qt) {
                u32x4 w;
                w.x = pk_bf16(s[qt][2 * pp][0], s[qt][2 * pp][1]); w.y = pk_bf16(s[qt][2 * pp][2], s[qt][2 * pp][3]);
                w.z = pk_bf16(s[qt][2 * pp + 1][0], s[qt][2 * pp + 1][1]); w.w = pk_bf16(s[qt][2 * pp + 1][2], s[qt][2 * pp + 1][3]);
                pf[qt] = __builtin_bit_cast(bf16x8, w);
            }
#pragma unroll
            for (int dt = 0; dt < 4; ++dt) {
                const bf16_t* vp = Vt + (16 * dt + fr) * 168 + 32 * pp + 4 * fq;
                const u32x2 v0 = *(const u32x2*)vp, v1 = *(const u32x2*)(vp + 16);
                const u32x4 vw = {v0.x, v0.y, v1.x, v1.y};
                const bf16x8 vf = __builtin_bit_cast(bf16x8, vw);
#pragma unroll
                for (int qt = 0; qt < 2; ++qt) o[qt][dt] = __builtin_amdgcn_mfma_f32_16x16x32_bf16(vf, pf[qt], o[qt][dt], 0, 0, 0);
            }
        }
#pragma unroll
        for (int qt = 0; qt < 2; ++qt) {
            const int i = qt * 16 + fr;
            const bool ok = samp ? (i < 8) : (t0 + i < LP);
            if (ok) {
                bf16_t* op = MIX + (size_t)(rowbase + (samp ? 0 : t0) + i) * 1024 + h * 64 + 4 * fq;
#pragma unroll
                for (int dt = 0; dt < 4; ++dt) *(u32x2*)(op + 16 * dt) = pk4(o[qt][dt] * inv[qt]);
            }
        }
    }
}

DEVI void final_phase(const Params& p) {
    const int tid = threadIdx.x, lane = tid & 63, wid = tid >> 6;
    const float* H = (const float*)(p.ws + OFF_H);
    const float* rowss = (const float*)(p.ws + OFF_RS);
    for (int u = blockIdx.x; u < MT / 4; u += gridDim.x) {
        const int row = u * 4 + wid;
        float* dst;
        if (row < MP) { const int b = row / LP, t = row - b * LP; if (t < 16) continue; dst = p.out + O_YP + ((size_t)b * 2048 + (t - 16)) * DM; }
        else dst = p.out + O_YS + (size_t)(row - MP) * DM;
        const float rs = row_rs(rowss, row);
#pragma unroll
        for (int i = 0; i < 4; ++i) {
            const int c = i * 256 + lane * 4;
            const f32x4 v = *(const f32x4*)(H + (size_t)row * DM + c);
            const f32x4 g = *(const f32x4*)(p.ln_f + c);
            *(f32x4*)(dst + c) = v * rs * g;
        }
    }
}

__global__ void __launch_bounds__(256, 2) hymba_fwd(Params p) {
    __shared__ __attribute__((aligned(16))) unsigned char lds[LDS_BYTES];
    cg::grid_group grid = cg::this_grid();
    float* H = (float*)(p.ws + OFF_H);
    bf16_t* Hb = (bf16_t*)(p.ws + OFF_HB);
    float* rowss = (float*)(p.ws + OFF_RS);
    const float* rope = (const float*)(p.ws + OFF_ROPE);
    bf16_t* Q = (bf16_t*)(p.ws + OFF_OV + OV_Q);
    bf16_t* Kb = (bf16_t*)(p.ws + OFF_OV + OV_K);
    bf16_t* Vb = (bf16_t*)(p.ws + OFF_OV + OV_V);
    bf16_t* U = (bf16_t*)(p.ws + OFF_OV + OV_U);
    bf16_t* MIX = (bf16_t*)(p.ws + OFF_OV + OV_MIX);
    bf16_t* ACT = (bf16_t*)(p.ws + OFF_OV);

    prologue(p, lds);
    grid.sync();
#pragma unroll 1
    for (int l = 0; l < 2; ++l) {
        { EpiIn e{rowss, rope, Q, Kb, Vb, U, p.out, l}; gemm_phase(Hb, wt_in(p.ws, l), NM, INW / 128, DM, e, lds); }
        grid.sync();
        mixer_phase(p, l, lds);
        grid.sync();
        { EpiRes e{H, Hb, rowss}; gemm_phase(MIX, wt_out(p.ws, l), NM, DM / 128, DM, e, lds); }
        grid.sync();
        { EpiUp e{rowss, ACT}; gemm_phase(Hb, wt_up(p.ws, l), NM, DFF / 128, DM, e, lds); }
        grid.sync();
        { EpiRes e{H, Hb, rowss}; gemm_phase(ACT, wt_dn(p.ws, l), NM, DM / 128, DFF, e, lds); }
        grid.sync();
    }
    final_phase(p);
}

extern "C" void kernel_launch(void* const* d_in, const int* in_sizes, int n_in, void* d_out, int out_size, void* d_ws, size_t ws_size, hipStream_t stream) {
    if (ws_size < WS_NEED || (size_t)out_size != O_END || n_in != 16) {
        fprintf(stderr, "kernel_launch: unexpected sizes ws=%zu need=%zu out=%d need=%zu n_in=%d\n", ws_size, WS_NEED, out_size, O_END, n_in);
        return;
    }
    static int grid_blocks = 0;
    if (!grid_blocks) {
        int dev = 0, cus = 0, per_cu = 0;
        hipGetDevice(&dev);
        hipDeviceGetAttribute(&cus, hipDeviceAttributeMultiprocessorCount, dev);
        hipOccupancyMaxActiveBlocksPerMultiprocessor(&per_cu, hymba_fwd, 256, 0);
        if (per_cu > 4) per_cu = 4;
        grid_blocks = cus * per_cu;
    }
    Params p{};
    p.x_prompt = (const float*)d_in[0]; p.x_sample = (const float*)d_in[1]; p.cache_k = (const float*)d_in[2]; p.cache_v = (const float*)d_in[3];
    p.state_pool = (const float*)d_in[4]; p.meta = (const float*)d_in[5]; p.ln1 = (const float*)d_in[6]; p.w_in = (const float*)d_in[7];
    p.sinks = (const float*)d_in[8]; p.pool_w = (const float*)d_in[9]; p.pool_scale = (const float*)d_in[10]; p.w_out = (const float*)d_in[11];
    p.ln2 = (const float*)d_in[12]; p.w_up = (const float*)d_in[13]; p.w_down = (const float*)d_in[14]; p.ln_f = (const float*)d_in[15];
    p.out = (float*)d_out; p.ws = (unsigned char*)d_ws;
    void* args[] = {&p};
    hipError_t e = hipLaunchCooperativeKernel((const void*)hymba_fwd, dim3(grid_blocks), dim3(256), args, 0, stream);
    if (e != hipSuccess) fprintf(stderr, "cooperative launch failed: %s (grid %d)\n", hipGetErrorString(e), grid_blocks);
}
```

```cpp
#include <hip/hip_runtime.h>
#include <hip/hip_cooperative_groups.h>
#include <cstdio>
#include <cstdint>
namespace cg = cooperative_groups;

typedef unsigned short bf16_t;
typedef short bf16x8 __attribute__((ext_vector_type(8)));
typedef float f32x4 __attribute__((ext_vector_type(4)));
typedef unsigned u32x4 __attribute__((ext_vector_type(4)));
typedef unsigned u32x2 __attribute__((ext_vector_type(2)));
#define DEVI __device__ __forceinline__
#define LAS __attribute__((address_space(3)))

constexpr int DM = 1024, LP = 2064, NBATCH = 16, MP = NBATCH * LP  , DB = 128, DS = 8, MS = DB * DS  ;
constexpr int MT = MP + MS  , INW = 1280, DFF = 4096, NM = MT / 128  ;
constexpr int NROPE = LP + DS;
constexpr float EPS = 1e-5f;

constexpr size_t O_YP = 0;
constexpr size_t O_YS = O_YP + (size_t)16 * 2048 * 1024;
constexpr size_t O_NKP = O_YS + (size_t)128 * 8 * 1024;
constexpr size_t O_NVP = O_NKP + (size_t)2 * 16 * 128 * 128;
constexpr size_t O_NPP = O_NVP + (size_t)2 * 16 * 128 * 128;
constexpr size_t O_NKS = O_NPP + (size_t)2 * 16 * 15 * 512;
constexpr size_t O_NVS = O_NKS + (size_t)2 * 128 * 128 * 128;
constexpr size_t O_NPS = O_NVS + (size_t)2 * 128 * 128 * 128;
constexpr size_t O_END = O_NPS + (size_t)2 * 128 * 15 * 512;

constexpr size_t WIN_E = (size_t)INW * DM, WOUT_E = (size_t)DM * DM, WUP_E = (size_t)DFF * DM, WDN_E = (size_t)DM * DFF;
constexpr size_t WL_E = WIN_E + WOUT_E + WUP_E + WDN_E;
constexpr size_t OFF_W = 0;
constexpr size_t OFF_H = OFF_W + 2 * WL_E * 2;
constexpr size_t OFF_HB = OFF_H + (size_t)MT * DM * 4;
constexpr size_t OFF_RS = OFF_HB + (size_t)MT * DM * 2;
constexpr size_t OFF_ROPE = OFF_RS + (size_t)MT * 16 * 4;
constexpr size_t OFF_OV = OFF_ROPE + (size_t)NROPE * 16 * 4;
constexpr size_t OV_Q = 0;
constexpr size_t OV_K = OV_Q + (size_t)MT * 512 * 2;
constexpr size_t OV_V = OV_K + (size_t)MT * 128 * 2;
constexpr size_t OV_U = OV_V + (size_t)MT * 128 * 2;
constexpr size_t OV_MIX = OV_U + (size_t)MT * 512 * 2;
constexpr size_t OV_END = OV_MIX + (size_t)MT * 1024 * 2;
constexpr size_t WS_NEED = OFF_OV + (size_t)MT * DFF * 2;
static_assert(OV_END <= (size_t)MT * DFF * 2, "overlay");

constexpr int LDS_BYTES = 131072;
constexpr int NTHR = 512;

struct Params {
    const float *x_prompt, *x_sample, *cache_k, *cache_v, *state_pool, *meta, *ln1, *w_in, *sinks, *pool_w, *pool_scale, *w_out, *ln2, *w_up, *w_down, *ln_f;
    float* out;
    unsigned char* ws;
};

DEVI unsigned pk_bf16(float lo, float hi) { unsigned r; asm("v_cvt_pk_bf16_f32 %0, %1, %2" : "=v"(r) : "v"(lo), "v"(hi)); return r; }
DEVI float bf_lo(unsigned w) { return __uint_as_float(w << 16); }
DEVI float bf_hi(unsigned w) { return __uint_as_float(w & 0xffff0000u); }
DEVI int opaque_tid() { int t = threadIdx.x; asm volatile("" : "+v"(t)); return t; }
DEVI u32x2 pk4(f32x4 v) { u32x2 r; r.x = pk_bf16(v[0], v[1]); r.y = pk_bf16(v[2], v[3]); return r; }

constexpr int BM = 256, BK = 64, HALF = 128, HTB = HALF * BK * 2, NXCD = 8, WGM = 8;
DEVI int lds_byte(int r, int c) { const int st = (r >> 4) * 2 + (c >> 5), rr = r & 15, cc = c & 31, ob = rr * 64 + cc * 2; return st * 1024 + (ob ^ (((ob >> 9) & 1) << 5)); }
DEVI void stage_rc(int b, int& R, int& C) { const int st = b / 1024, sb = b % 1024, swz = sb ^ (((sb >> 9) & 1) << 5); R = (st >> 1) * 16 + swz / 64; C = (st & 1) * 32 + (swz % 64) / 2; }
DEVI int perm32(int rho) { const int n = rho >> 4, i = rho & 15; return 8 * (i >> 2) + 4 * n + (i & 3); }
struct Unit { int pm, pn; };
struct Gemm { const bf16_t* A; const bf16_t* Bt; int M, N, K; };
struct StaticOrder {
    int nM, nN, nwg, G, c;
    DEVI void init(int M, int N, int G_, int c_) { nM = M / BM; nN = N / BM; nwg = nM * nN; G = G_; c = c_; }
    DEVI bool next(int i, Unit& u) const {
        const long L = (long)i * G + c; if (L >= nwg) return false;
        int wgid = (int)L; { const int q = nwg / NXCD, r = nwg % NXCD, xcd = wgid % NXCD, off = wgid / NXCD; wgid = (xcd < r ? xcd * (q + 1) : r * (q + 1) + (xcd - r) * q) + off; }
        const int nig = WGM * nN, gid = wgid / nig, fm = gid * WGM, gsz = (nM - fm) < WGM ? (nM - fm) : WGM;
        u.pm = fm + ((wgid % nig) % gsz); u.pn = (wgid % nig) / gsz; return true;
    }
};
template <class Epi>
DEVI void gemm_phase(LAS unsigned char* lds, const Gemm g, const StaticOrder& S, const Epi& E) {
    const int tid = opaque_tid(), wid = __builtin_amdgcn_readfirstlane(tid >> 6), lane = tid & 63, wr = wid >> 2, wc = wid & 3, fr = lane & 15, fq = lane >> 4;
    const int K = g.K, nt = K / BK;
    unsigned voffA[2], voffB[2];
#pragma unroll
    for (int i = 0; i < 2; ++i) { int R, C; stage_rc(tid * 16 + i * 8192, R, C); const int Rb = (R & ~31) + perm32(R & 31);
        voffA[i] = (unsigned)(R * K + C) * 2u; voffB[i] = (unsigned)(Rb * K + C) * 2u; }
    const size_t kstep = (size_t)(BK * 2);
    const size_t hstep = (size_t)HALF * K * 2;
    const size_t tstep = 2 * hstep;
    const unsigned ldsw = (unsigned)wid * 1024u;
    const int aoff = lds_byte(wr * 64 + fr, fq * 8), boff = lds_byte(wc * 32 + fr, fq * 8);
#define PG8_SA(b, h) (((b) * 2 + (h)) * HTB)
#define PG8_SB(b, h) ((4 + (b) * 2 + (h)) * HTB)
#define PG8_STAGE(bufoff, gbase, voff) do { _Pragma("unroll") for (int _i = 0; _i < 2; ++_i) \
        __builtin_amdgcn_global_load_lds((const unsigned*)((const char*)(gbase) + (voff)[_i]), (LAS unsigned*)(lds + (bufoff) + ldsw + _i * 8192), 16, 0, 0); } while (0)
#define PG8_LDA(dst, b, h) do { _Pragma("unroll") for (int m = 0; m < 4; ++m) _Pragma("unroll") for (int k = 0; k < 2; ++k) dst[m][k] = *(const LAS bf16x8*)(lds + PG8_SA(b, h) + aoff + m * 2048 + k * 1024); } while (0)
#define PG8_LDB(dst, b, h) do { _Pragma("unroll") for (int n = 0; n < 2; ++n) _Pragma("unroll") for (int k = 0; k < 2; ++k) dst[n][k] = *(const LAS bf16x8*)(lds + PG8_SB(b, h) + boff + n * 2048 + k * 1024); } while (0)
#define PG8_MMA(ai, bj, At, Bt) do { __builtin_amdgcn_s_setprio(1); _Pragma("unroll") for (int m = 0; m < 4; ++m) _Pragma("unroll") for (int n = 0; n < 2; ++n) _Pragma("unroll") for (int k = 0; k < 2; ++k) \
        acc[ai][bj][m][n] = __builtin_amdgcn_mfma_f32_16x16x32_bf16(Bt[n][k], At[m][k], acc[ai][bj][m][n], 0, 0, 0); __builtin_amdgcn_s_setprio(0); } while (0)
#define PG8_WAIT_V(n) asm volatile("s_waitcnt vmcnt(" #n ")" ::: "memory")
#define PG8_WAIT_L(n) asm volatile("s_waitcnt lgkmcnt(" #n ")" ::: "memory")
#define PG8_BAR __builtin_amdgcn_s_barrier()
#define PG8_SCHED __builtin_amdgcn_sched_barrier(0)
    Unit cur, nxt; int ui = 0;
    if (!S.next(0, cur)) return;
    f32x4 acc[2][2][4][2];
#pragma unroll
    for (int a = 0; a < 2; ++a)
#pragma unroll
        for (int b = 0; b < 2; ++b)
#pragma unroll
            for (int m = 0; m < 4; ++m)
#pragma unroll
                for (int n = 0; n < 2; ++n) acc[a][b][m][n] = (f32x4){0.f, 0.f, 0.f, 0.f};
    bf16x8 At[4][2], B0[2][2], B1[2][2];
    const char* cA = (const char*)g.A + (size_t)cur.pm * tstep; const char* cB = (const char*)g.Bt + (size_t)cur.pn * tstep;
    PG8_STAGE(PG8_SB(0, 0), cB, voffB); PG8_STAGE(PG8_SA(0, 0), cA, voffA); PG8_STAGE(PG8_SB(0, 1), cB + hstep, voffB); PG8_STAGE(PG8_SA(0, 1), cA + hstep, voffA);
    if (wr == 1) PG8_BAR;
    PG8_WAIT_V(4); PG8_BAR;
    PG8_STAGE(PG8_SB(1, 0), cB + kstep, voffB); PG8_STAGE(PG8_SA(1, 0), cA + kstep, voffA); PG8_STAGE(PG8_SB(1, 1), cB + hstep + kstep, voffB);
    PG8_WAIT_V(6); PG8_BAR;
    for (;;) {
        const bool has_next = S.next(ui + 1, nxt);
        const char* nA = has_next ? (const char*)g.A + (size_t)nxt.pm * tstep : cA; const char* nB = has_next ? (const char*)g.Bt + (size_t)nxt.pn * tstep : cB;
        for (int t = 0; t < nt; t += 2) {
            const bool last = (t == nt - 2);
            const char* a1 = cA + (size_t)(t + 1) * kstep;
            const char* a2 = last ? nA : cA + (size_t)(t + 2) * kstep; const char* b2 = last ? nB : cB + (size_t)(t + 2) * kstep;
            const char* a3 = a2 + kstep; const char* b3 = b2 + kstep;
            PG8_LDB(B0, 0, 0); PG8_SCHED; PG8_LDA(At, 0, 0); PG8_STAGE(PG8_SA(1, 1), a1 + hstep, voffA);
            PG8_WAIT_L(8); PG8_BAR; PG8_WAIT_L(0); PG8_MMA(0, 0, At, B0); PG8_BAR; PG8_SCHED;
            PG8_LDB(B1, 0, 1); PG8_STAGE(PG8_SB(0, 0), b2, voffB);
            PG8_BAR; PG8_WAIT_L(0); PG8_MMA(0, 1, At, B1); PG8_BAR;
            PG8_LDA(At, 0, 1); PG8_STAGE(PG8_SA(0, 0), a2, voffA);
            PG8_BAR; PG8_WAIT_L(0); PG8_MMA(1, 0, At, B0); PG8_BAR; PG8_SCHED;
            PG8_STAGE(PG8_SB(0, 1), b2 + hstep, voffB);
            PG8_WAIT_V(6); PG8_BAR; PG8_MMA(1, 1, At, B1); PG8_BAR;
            PG8_LDB(B0, 1, 0); PG8_SCHED; PG8_LDA(At, 1, 0); PG8_STAGE(PG8_SA(0, 1), a2 + hstep, voffA);
            PG8_WAIT_L(8); PG8_BAR; PG8_WAIT_L(0); PG8_MMA(0, 0, At, B0); PG8_BAR; PG8_SCHED;
            PG8_LDB(B1, 1, 1); PG8_STAGE(PG8_SB(1, 0), b3, voffB);
            PG8_BAR; PG8_WAIT_L(0); PG8_MMA(0, 1, At, B1); PG8_BAR;
            PG8_LDA(At, 1, 1); PG8_STAGE(PG8_SA(1, 0), a3, voffA);
            PG8_BAR; PG8_WAIT_L(0); PG8_MMA(1, 0, At, B0); PG8_BAR; PG8_SCHED;
            PG8_STAGE(PG8_SB(1, 1), b3 + hstep, voffB);
            PG8_WAIT_V(6); PG8_BAR; PG8_MMA(1, 1, At, B1); PG8_BAR;
        }
        E(acc, cur, wr, wc, fr, fq);
        if (!has_next) break;
#pragma unroll
        for (int a = 0; a < 2; ++a)
#pragma unroll
            for (int b = 0; b < 2; ++b)
#pragma unroll
                for (int m = 0; m < 4; ++m)
#pragma unroll
                    for (int n = 0; n < 2; ++n) acc[a][b][m][n] = (f32x4){0.f, 0.f, 0.f, 0.f};
        cur = nxt; cA = nA; cB = nB; ++ui;
    }
    PG8_WAIT_V(0);
    if (wr == 0) PG8_BAR;
    PG8_BAR;
#undef PG8_SA
#undef PG8_SB
#undef PG8_STAGE
#undef PG8_LDA
#undef PG8_LDB
#undef PG8_MMA
#undef PG8_WAIT_V
#undef PG8_WAIT_L
#undef PG8_BAR
#undef PG8_SCHED
}

DEVI float row_rs(const float* rowss, int row) {
    const f32x4* rp = (const f32x4*)(rowss + (size_t)row * 16);
    const f32x4 a = (rp[0] + rp[1]) + (rp[2] + rp[3]);
    const float ss = (a[0] + a[1]) + (a[2] + a[3]);
    return rsqrtf(ss * (1.f / 1024.f) + EPS);
}
DEVI float row_rs4(const float* rowss, int row, int fq) {
    const f32x4 a = *(const f32x4*)(rowss + (size_t)row * 16 + fq * 4);
    float ss = (a[0] + a[1]) + (a[2] + a[3]);
    ss += __shfl_xor(ss, 16);
    ss += __shfl_xor(ss, 32);
    return rsqrtf(ss * (1.f / 1024.f) + EPS);
}
DEVI u32x4 pk8(f32x4 a, f32x4 b) { u32x4 r; r.x = pk_bf16(a[0], a[1]); r.y = pk_bf16(a[2], a[3]); r.z = pk_bf16(b[0], b[1]); r.w = pk_bf16(b[2], b[3]); return r; }

struct EpiIn {
    const float* rowss; const float* rope; bf16_t *Q, *Kb, *Vb, *U; float* out; int l;
    DEVI void operator()(const f32x4 (&acc)[2][2][4][2], const Unit& u, int wr, int wc, int fr, int fq) const {
#pragma unroll
        for (int ai = 0; ai < 2; ++ai)
#pragma unroll
            for (int m = 0; m < 4; ++m) {
                const int row = u.pm * 256 + ai * 128 + wr * 64 + m * 16 + fr;
                const float rs = row_rs4(rowss, row, fq);
                const bool samp = row >= MP;
                int b, t;
                if (!samp) { b = row / LP; t = row - b * LP; } else { const int r = row - MP; b = r >> 3; t = r & 7; }
                const int pidx = samp ? LP + t : t;
#pragma unroll
                for (int bj = 0; bj < 2; ++bj) {
                    const int cb = u.pn * 256 + bj * 128 + wc * 32;
                    f32x4 v0 = acc[ai][bj][m][0] * rs, v1 = acc[ai][bj][m][1] * rs;
                    if (cb < 640 && (wc & 1) == 0) {
                        const f32x4 c0 = *(const f32x4*)(rope + pidx * 16), c1 = *(const f32x4*)(rope + pidx * 16 + 4);
                        const f32x4 s0 = *(const f32x4*)(rope + pidx * 16 + 8), s1 = *(const f32x4*)(rope + pidx * 16 + 12);
                        f32x4 p0, p1;
#pragma unroll
                        for (int jj = 0; jj < 4; ++jj) { p0[jj] = __shfl_xor(v0[jj], 16); p1[jj] = __shfl_xor(v1[jj], 16); }
                        if (fq < 2) {
                            const float sg = fq == 0 ? -1.f : 1.f;
                            v0 = v0 * c0 + p0 * s0 * sg; v1 = v1 * c1 + p1 * s1 * sg;
                        }
                    }
                    if (cb < 512) {
                        *(u32x4*)(Q + (size_t)row * 512 + cb + 8 * fq) = pk8(v0 * 0.125f, v1 * 0.125f);
                    } else if (cb < 768) {
                        const bool isk = cb < 640;
                        const int kc = (isk ? cb - 512 : cb - 640) + 8 * fq;
                        *(u32x4*)((isk ? Kb : Vb) + (size_t)row * 128 + kc) = pk8(v0, v1);
                        float* dst = nullptr;
                        if (!samp) { if (t >= LP - 128) dst = out + (isk ? O_NKP : O_NVP) + ((size_t)((l * 16 + b) * 128 + (t - (LP - 128)))) * 128; }
                        else dst = out + (isk ? O_NKS : O_NVS) + ((size_t)((l * 128 + b) * 128 + 120 + t)) * 128;
                        if (dst) { *(f32x4*)(dst + kc) = v0; *(f32x4*)(dst + kc + 4) = v1; }
                    } else {
                        const int uc = cb - 768 + 8 * fq;
                        *(u32x4*)(U + (size_t)row * 512 + uc) = pk8(v0, v1);
                        float* dst = nullptr;
                        if (!samp) { if (t >= LP - 15) dst = out + O_NPP + ((size_t)((l * 16 + b) * 15 + (t - (LP - 15)))) * 512; }
                        else dst = out + O_NPS + ((size_t)((l * 128 + b) * 15 + 7 + t)) * 512;
                        if (dst) { *(f32x4*)(dst + uc) = v0; *(f32x4*)(dst + uc + 4) = v1; }
                    }
                }
            }
    }
};

struct EpiRes {
    float* H; bf16_t* Hb; float* rowss;
    DEVI void operator()(const f32x4 (&acc)[2][2][4][2], const Unit& u, int wr, int wc, int fr, int fq) const {
#pragma unroll
        for (int ai = 0; ai < 2; ++ai)
#pragma unroll
            for (int m = 0; m < 4; ++m) {
                const int row = u.pm * 256 + ai * 128 + wr * 64 + m * 16 + fr;
                float ss = 0.f;
#pragma unroll
                for (int bj = 0; bj < 2; ++bj) {
                    const size_t o = (size_t)row * DM + u.pn * 256 + bj * 128 + wc * 32 + 8 * fq;
                    f32x4 h0 = *(const f32x4*)(H + o), h1 = *(const f32x4*)(H + o + 4);
                    h0 = h0 + acc[ai][bj][m][0]; h1 = h1 + acc[ai][bj][m][1];
                    *(f32x4*)(H + o) = h0; *(f32x4*)(H + o + 4) = h1;
                    *(u32x4*)(Hb + o) = pk8(h0, h1);
                    ss += ((h0[0] * h0[0] + h0[1] * h0[1]) + (h0[2] * h0[2] + h0[3] * h0[3])) + ((h1[0] * h1[0] + h1[1] * h1[1]) + (h1[2] * h1[2] + h1[3] * h1[3]));
                }
                ss += __shfl_xor(ss, 16);
                ss += __shfl_xor(ss, 32);
                if (fq == 0) rowss[(size_t)row * 16 + u.pn * 4 + wc] = ss;
                if (m & 1) __builtin_amdgcn_sched_barrier(0);
            }
    }
};

struct EpiUp {
    const float* rowss; bf16_t* ACT;
    DEVI void operator()(const f32x4 (&acc)[2][2][4][2], const Unit& u, int wr, int wc, int fr, int fq) const {
#pragma unroll
        for (int ai = 0; ai < 2; ++ai)
#pragma unroll
            for (int m = 0; m < 4; ++m) {
                const int row = u.pm * 256 + ai * 128 + wr * 64 + m * 16 + fr;
                const float rs = row_rs4(rowss, row, fq);
#pragma unroll
                for (int bj = 0; bj < 2; ++bj) {
                    f32x4 a0 = acc[ai][bj][m][0] * rs, a1 = acc[ai][bj][m][1] * rs;
#pragma unroll
                    for (int e = 0; e < 4; ++e) { const float x = fmaxf(a0[e], 0.f); a0[e] = x * x; const float y = fmaxf(a1[e], 0.f); a1[e] = y * y; }
                    *(u32x4*)(ACT + (size_t)row * DFF + u.pn * 256 + bj * 128 + wc * 32 + 8 * fq) = pk8(a0, a1);
                }
            }
    }
};

DEVI void transpose_tile(const float* __restrict__ W, int N, const float* __restrict__ g, bf16_t* __restrict__ Wt, int ldk, int kt, int nt_, LAS float* t, int ltid) {
    __syncthreads();
    {
        const int ty = ltid >> 4, n4 = (ltid & 15) * 4;
#pragma unroll
        for (int i = 0; i < 4; ++i) {
            const int k = ty + 16 * i;
            f32x4 v = *(const f32x4*)(W + (size_t)(kt * 64 + k) * N + nt_ * 64 + n4);
            const float s = g ? g[kt * 64 + k] : 1.f;
            t[k * 65 + n4 + 0] = v[0] * s; t[k * 65 + n4 + 1] = v[1] * s; t[k * 65 + n4 + 2] = v[2] * s; t[k * 65 + n4 + 3] = v[3] * s;
        }
    }
    __syncthreads();
    {
        const int n = ltid >> 2, kq = (ltid & 3) * 16;
        u32x4 o0, o1;
        o0.x = pk_bf16(t[(kq + 0) * 65 + n], t[(kq + 1) * 65 + n]);   o0.y = pk_bf16(t[(kq + 2) * 65 + n], t[(kq + 3) * 65 + n]);
        o0.z = pk_bf16(t[(kq + 4) * 65 + n], t[(kq + 5) * 65 + n]);   o0.w = pk_bf16(t[(kq + 6) * 65 + n], t[(kq + 7) * 65 + n]);
        o1.x = pk_bf16(t[(kq + 8) * 65 + n], t[(kq + 9) * 65 + n]);   o1.y = pk_bf16(t[(kq + 10) * 65 + n], t[(kq + 11) * 65 + n]);
        o1.z = pk_bf16(t[(kq + 12) * 65 + n], t[(kq + 13) * 65 + n]); o1.w = pk_bf16(t[(kq + 14) * 65 + n], t[(kq + 15) * 65 + n]);
        bf16_t* d = Wt + (size_t)(nt_ * 64 + n) * ldk + kt * 64 + kq;
        *(u32x4*)d = o0; *(u32x4*)(d + 8) = o1;
    }
}

DEVI bf16_t* wt_in(unsigned char* ws, int l) { return (bf16_t*)(ws + OFF_W) + (size_t)l * WL_E; }
DEVI bf16_t* wt_out(unsigned char* ws, int l) { return wt_in(ws, l) + WIN_E; }
DEVI bf16_t* wt_up(unsigned char* ws, int l) { return wt_out(ws, l) + WOUT_E; }
DEVI bf16_t* wt_dn(unsigned char* ws, int l) { return wt_up(ws, l) + WUP_E; }

constexpr int U_TRL = (320 + 128 + 1024 + 1024) / 2;
constexpr int U_TR = 2 * U_TRL;
constexpr int U_WC = U_TR + 64;
constexpr int U_ROWS = U_WC + MT / 8;
constexpr int U_ROPE = U_ROWS + (NROPE * 8 + NTHR - 1) / NTHR;
constexpr int U_CK = U_ROPE + 256;
constexpr int U_CV = U_CK + 256;
constexpr int U_CP = U_CV + 256;

DEVI void prologue(const Params& p, LAS unsigned char* lds) {
    const int tid = opaque_tid(), lane = tid & 63, wid = tid >> 6, sb = tid >> 8, ltid = tid & 255;
    float* H = (float*)(p.ws + OFF_H);
    bf16_t* Hb = (bf16_t*)(p.ws + OFF_HB);
    float* rowss = (float*)(p.ws + OFF_RS);
    float* rope = (float*)(p.ws + OFF_ROPE);
    LAS float* tl = (LAS float*)(lds + sb * 16640);
    for (int u = blockIdx.x; u < U_CP; u += gridDim.x) {
        if (u < U_TR) {
            const int l = u / U_TRL; int r = (u - l * U_TRL) * 2 + sb;
            if (r < 320) { transpose_tile(p.w_in + (size_t)l * DM * INW, INW, p.ln1 + l * DM, wt_in(p.ws, l), DM, r & 15, r >> 4, tl, ltid); }
            else if ((r -= 320) < 128) { transpose_tile(p.w_out + (size_t)l * DM * DM, DM, nullptr, wt_out(p.ws, l), DM, r & 7, r >> 3, tl, ltid); }
            else if ((r -= 128) < 1024) { transpose_tile(p.w_up + (size_t)l * DM * DFF, DFF, p.ln2 + l * DM, wt_up(p.ws, l), DM, r & 15, r >> 4, tl, ltid); }
            else { r -= 1024; transpose_tile(p.w_down + (size_t)l * DFF * DM, DM, nullptr, wt_dn(p.ws, l), DFF, r & 63, r >> 6, tl, ltid); }
        } else if (u < U_WC) {
            const int r = u - U_TR, l = r >> 5, g = (r >> 3) & 3, n = (r & 7) * 128 + (wid >> 2) * 64 + lane, c0 = (wid & 3) * 32;
            const float* pw = p.pool_w + ((size_t)(l * 4 + g) * 128 + c0) * 128;
            const float* sc = p.pool_scale + l * 512 + g * 128;
            const float* wo = p.w_out + (size_t)l * DM * DM + (size_t)(512 + g * 128) * DM + n;
            float acc[32];
#pragma unroll
            for (int c = 0; c < 32; ++c) acc[c] = 0.f;
            for (int e = 0; e < 128; ++e) {
                const float w = wo[(size_t)e * DM] * sc[e];
#pragma unroll
                for (int c = 0; c < 32; ++c) acc[c] += pw[c * 128 + e] * w;
            }
            bf16_t* d = wt_out(p.ws, l) + (size_t)n * DM + 512 + g * 128 + c0;
#pragma unroll
            for (int c = 0; c < 32; c += 8) {
                u32x4 o; o.x = pk_bf16(acc[c], acc[c + 1]); o.y = pk_bf16(acc[c + 2], acc[c + 3]); o.z = pk_bf16(acc[c + 4], acc[c + 5]); o.w = pk_bf16(acc[c + 6], acc[c + 7]);
                *(u32x4*)(d + c) = o;
            }
        } else if (u < U_ROWS) {
            const int row = (u - U_WC) * 8 + wid;
            const float* src;
            if (row < MP) { const int b = row / LP, t = row - b * LP; src = t < 16 ? p.meta + (size_t)t * DM : p.x_prompt + ((size_t)b * 2048 + (t - 16)) * DM; }
            else src = p.x_sample + (size_t)(row - MP) * DM;
            float ss = 0.f;
#pragma unroll
            for (int i = 0; i < 4; ++i) {
                const int c = i * 256 + lane * 4;
                const f32x4 v = *(const f32x4*)(src + c);
                *(f32x4*)(H + (size_t)row * DM + c) = v;
                *(u32x2*)(Hb + (size_t)row * DM + c) = pk4(v);
                ss += (v[0] * v[0] + v[1] * v[1]) + (v[2] * v[2] + v[3] * v[3]);
            }
#pragma unroll
            for (int o = 32; o >= 1; o >>= 1) ss += __shfl_xor(ss, o);
            if (lane < 16) rowss[(size_t)row * 16 + lane] = lane == 0 ? ss : 0.f;
        } else if (u < U_ROPE) {
            const int id = (u - U_ROWS) * NTHR + tid;
            if (id < NROPE * 8) {
                const int idx = id >> 3, i = id & 7;
                const int pos = idx < LP ? idx : 16384 + (idx - LP);
                const float inv = exp2f(-(float)i * 0.125f * 18.931568569324174f);
                const float ang = (float)pos * inv;
                double rev = (double)ang * 0.15915494309189535;
                rev -= rint(rev);
                const float red = (float)(rev * 6.283185307179586);
                rope[idx * 16 + i] = __cosf(red);
                rope[idx * 16 + 8 + i] = __sinf(red);
            }
        } else if (u < U_CV) {
            const bool isk = u < U_CK;
            const int r = isk ? u - U_ROPE : u - U_CK;
            const f32x4* src = (const f32x4*)((isk ? p.cache_k : p.cache_v) + (size_t)r * 128 * 128 + 8 * 128);
            f32x4* dst = (f32x4*)(p.out + (isk ? O_NKS : O_NVS) + (size_t)r * 128 * 128);
            for (int i = tid; i < 120 * 32; i += NTHR) dst[i] = src[i];
        } else {
            const int r = u - U_CV;
            const f32x4* src = (const f32x4*)(p.state_pool + (size_t)r * 15 * 512 + 8 * 512);
            f32x4* dst = (f32x4*)(p.out + O_NPS + (size_t)r * 15 * 512);
            for (int i = tid; i < 7 * 128; i += NTHR) dst[i] = src[i];
        }
    }
    __syncthreads();
}

constexpr int N_PU = NBATCH * 65;
constexpr int N_AU = N_PU + DB;

DEVI void add8(f32x4& a0, f32x4& a1, const u32x4 w) {
    a0[0] += bf_lo(w.x); a0[1] += bf_hi(w.x); a0[2] += bf_lo(w.y); a0[3] += bf_hi(w.y);
    a1[0] += bf_lo(w.z); a1[1] += bf_hi(w.z); a1[2] += bf_lo(w.w); a1[3] += bf_hi(w.w);
}

DEVI void mixer_phase(const Params& p, const int l, LAS unsigned char* lds_all) {
    const int tid0 = opaque_tid(), tid = tid0 & 255, kvh = tid0 >> 8, lane = tid & 63, wid = tid >> 6, fr = lane & 15, fq = lane >> 4;
    const bf16_t* Q = (const bf16_t*)(p.ws + OFF_OV + OV_Q);
    const bf16_t* Kb = (const bf16_t*)(p.ws + OFF_OV + OV_K);
    const bf16_t* Vb = (const bf16_t*)(p.ws + OFF_OV + OV_V);
    const bf16_t* U = (const bf16_t*)(p.ws + OFF_OV + OV_U);
    bf16_t* MIX = (bf16_t*)(p.ws + OFF_OV + OV_MIX);
    LAS unsigned char* Ks = lds_all + kvh * 44544;
    LAS bf16_t* Vt = (LAS bf16_t*)(Ks + 160 * 144);
    for (int unit = blockIdx.x; unit < N_AU; unit += gridDim.x) {
        const bool samp = unit >= N_PU;
        int b, t0;
        if (!samp) { b = unit / 65; t0 = (unit - b * 65) * 32; }
        else { b = unit - N_PU; t0 = 0; }
        const int rowbase = samp ? MP + b * 8 : b * LP;

        if (!samp) {
#pragma unroll 1
            for (int i = 0; i < 4; ++i) {
                const int c = tid + 256 * i, ir = c >> 5, ch = kvh * 256 + (c & 31) * 8, g = ch >> 7, w = 2 << g, pos = t0 + ir;
                if (pos < LP) {
                    const int n = (pos + 1) < w ? (pos + 1) : w;
                    const bf16_t* up = U + (size_t)(rowbase + pos) * 512 + ch;
                    f32x4 a0 = {0.f, 0.f, 0.f, 0.f}, a1 = {0.f, 0.f, 0.f, 0.f}, u0 = a0, u1 = a0;
                    add8(u0, u1, *(const u32x4*)up);
                    for (int ii = 1; ii < n; ++ii) add8(a0, a1, *(const u32x4*)(up - (size_t)ii * 512));
                    const float inv = 1.f / (float)n;
                    a0 = (a0 + u0) * inv - u0; a1 = (a1 + u1) * inv - u1;
                    *(u32x4*)(MIX + (size_t)(rowbase + pos) * 1024 + 512 + ch) = pk8(a0, a1);
                }
            }
        } else {
            const int s = tid >> 5, ch = kvh * 256 + (tid & 31) * 8, g = ch >> 7, w = 2 << g;
            f32x4 a0 = {0.f, 0.f, 0.f, 0.f}, a1 = {0.f, 0.f, 0.f, 0.f}, u0 = a0, u1 = a0;
            add8(u0, u1, *(const u32x4*)(U + (size_t)(rowbase + s) * 512 + ch));
            for (int ii = 1; ii < w; ++ii) {
                const int r = s - ii;
                if (r >= 0) add8(a0, a1, *(const u32x4*)(U + (size_t)(rowbase + r) * 512 + ch));
                else { const float* sp = p.state_pool + ((size_t)(l * 128 + b) * 15 + (15 + r)) * 512 + ch; a0 = a0 + *(const f32x4*)sp; a1 = a1 + *(const f32x4*)(sp + 4); }
            }
            const float inv = 1.f / (float)w;
            a0 = (a0 + u0) * inv - u0; a1 = (a1 + u1) * inv - u1;
            *(u32x4*)(MIX + (size_t)(rowbase + s) * 1024 + 512 + ch) = pk8(a0, a1);
        }

        u32x4 kq[5], vq[5];
#pragma unroll
        for (int i = 0; i < 5; ++i) {
            const int c = tid + 256 * i, j = c >> 3, dc = c & 7;
            kq[i] = (u32x4){0u, 0u, 0u, 0u}; vq[i] = kq[i];
            if (!samp) {
                const int kpos = t0 - 128 + j;
                if (kpos >= 0 && kpos < LP) {
                    const size_t o = (size_t)(rowbase + kpos) * 128 + kvh * 64 + dc * 8;
                    kq[i] = *(const u32x4*)(Kb + o); vq[i] = *(const u32x4*)(Vb + o);
                }
            } else if (j < 128) {
                const size_t o = (((size_t)(l * 128 + b) * 128 + j) * 2 + kvh) * 64 + dc * 8;
                const f32x4 k0 = *(const f32x4*)(p.cache_k + o), k1 = *(const f32x4*)(p.cache_k + o + 4);
                const f32x4 v0 = *(const f32x4*)(p.cache_v + o), v1 = *(const f32x4*)(p.cache_v + o + 4);
                kq[i] = pk8(k0, k1); vq[i] = pk8(v0, v1);
            } else if (j < 136) {
                const size_t o = (size_t)(rowbase + j - 128) * 128 + kvh * 64 + dc * 8;
                kq[i] = *(const u32x4*)(Kb + o); vq[i] = *(const u32x4*)(Vb + o);
            }
        }
        const int h = kvh * 4 + wid;
        bf16x8 qf[2][2];
#pragma unroll
        for (int qt = 0; qt < 2; ++qt) {
            const int i = qt * 16 + fr;
            const bool ok = samp ? (i < 8) : (t0 + i < LP);
            const bf16_t* qp = Q + (size_t)(rowbase + (samp ? 0 : t0) + i) * 512 + h * 64 + fq * 8;
#pragma unroll
            for (int ks = 0; ks < 2; ++ks) {
                u32x4 w = {0u, 0u, 0u, 0u};
                if (ok) w = *(const u32x4*)(qp + ks * 32);
                qf[qt][ks] = __builtin_bit_cast(bf16x8, w);
            }
        }
        __syncthreads();
#pragma unroll
        for (int i = 0; i < 5; ++i) {
            const int c = tid + 256 * i, j = c >> 3, dc = c & 7;
            *(LAS u32x4*)(Ks + j * 144 + dc * 16) = kq[i];
            LAS bf16_t* vt = Vt + (dc * 8) * 168 + j;
            vt[0 * 168] = (bf16_t)(vq[i].x & 0xffff); vt[1 * 168] = (bf16_t)(vq[i].x >> 16);
            vt[2 * 168] = (bf16_t)(vq[i].y & 0xffff); vt[3 * 168] = (bf16_t)(vq[i].y >> 16);
            vt[4 * 168] = (bf16_t)(vq[i].z & 0xffff); vt[5 * 168] = (bf16_t)(vq[i].z >> 16);
            vt[6 * 168] = (bf16_t)(vq[i].w & 0xffff); vt[7 * 168] = (bf16_t)(vq[i].w >> 16);
        }
        __syncthreads();

        f32x4 s[2][10];
#pragma unroll
        for (int t = 0; t < 10; ++t) {
            const bf16x8 k0 = *(const LAS bf16x8*)(Ks + (16 * t + fr) * 144 + fq * 16);
            const bf16x8 k1 = *(const LAS bf16x8*)(Ks + (16 * t + fr) * 144 + 64 + fq * 16);
#pragma unroll
            for (int qt = 0; qt < 2; ++qt) {
                f32x4 z = {0.f, 0.f, 0.f, 0.f};
                z = __builtin_amdgcn_mfma_f32_16x16x32_bf16(k0, qf[qt][0], z, 0, 0, 0);
                s[qt][t] = __builtin_amdgcn_mfma_f32_16x16x32_bf16(k1, qf[qt][1], z, 0, 0, 0);
            }
        }
        const float sink = p.sinks[l * 8 + h];
        float inv[2];
#pragma unroll
        for (int qt = 0; qt < 2; ++qt) {
            const int i = qt * 16 + fr;
            float mx = -INFINITY;
#pragma unroll
            for (int t = 0; t < 10; ++t)
#pragma unroll
                for (int jj = 0; jj < 4; ++jj) {
                    const int j = 16 * t + 4 * fq + jj;
                    const bool ok = (j >= i) && (j <= i + 128) && (samp || (t0 - 128 + j >= 0));
                    const float x = ok ? s[qt][t][jj] : -INFINITY;
                    s[qt][t][jj] = x;
                    mx = fmaxf(mx, x);
                }
            mx = fmaxf(mx, __shfl_xor(mx, 16));
            mx = fmaxf(mx, __shfl_xor(mx, 32));
            const float m = fmaxf(mx, sink);
            float sum = 0.f;
#pragma unroll
            for (int t = 0; t < 10; ++t)
#pragma unroll
                for (int jj = 0; jj < 4; ++jj) { const float e = __expf(s[qt][t][jj] - m); s[qt][t][jj] = e; sum += e; }
            sum += __shfl_xor(sum, 16);
            sum += __shfl_xor(sum, 32);
            inv[qt] = 1.f / (sum + __expf(sink - m));
        }
        f32x4 o[2][4];
#pragma unroll
        for (int qt = 0; qt < 2; ++qt)
#pragma unroll
            for (int dt = 0; dt < 4; ++dt) o[qt][dt] = (f32x4){0.f, 0.f, 0.f, 0.f};
#pragma unroll
        for (int pp = 0; pp < 5; ++pp) {
            bf16x8 pf[2];
#pragma unroll
            for (int qt = 0; qt < 2; ++qt) pf[qt] = __builtin_bit_cast(bf16x8, pk8(s[qt][2 * pp], s[qt][2 * pp + 1]));
#pragma unroll
            for (int dt = 0; dt < 4; ++dt) {
                const LAS bf16_t* vp = Vt + (16 * dt + fr) * 168 + 32 * pp + 4 * fq;
                const u32x2 v0 = *(const LAS u32x2*)vp, v1 = *(const LAS u32x2*)(vp + 16);
                const u32x4 vw = {v0.x, v0.y, v1.x, v1.y};
                const bf16x8 vf = __builtin_bit_cast(bf16x8, vw);
#pragma unroll
                for (int qt = 0; qt < 2; ++qt) o[qt][dt] = __builtin_amdgcn_mfma_f32_16x16x32_bf16(vf, pf[qt], o[qt][dt], 0, 0, 0);
            }
        }
#pragma unroll
        for (int qt = 0; qt < 2; ++qt) {
            const int i = qt * 16 + fr;
            const bool ok = samp ? (i < 8) : (t0 + i < LP);
            if (ok) {
                bf16_t* op = MIX + (size_t)(rowbase + (samp ? 0 : t0) + i) * 1024 + h * 64 + 4 * fq;
#pragma unroll
                for (int dt = 0; dt < 4; ++dt) *(u32x2*)(op + 16 * dt) = pk4(o[qt][dt] * inv[qt]);
            }
        }
    }
    __syncthreads();
}

DEVI void final_phase(const Params& p) {
    const int tid = opaque_tid(), lane = tid & 63, wid = tid >> 6;
    const float* H = (const float*)(p.ws + OFF_H);
    const float* rowss = (const float*)(p.ws + OFF_RS);
    for (int u = blockIdx.x; u < MT / 8; u += gridDim.x) {
        const int row = u * 8 + wid;
        float* dst;
        if (row < MP) { const int b = row / LP, t = row - b * LP; if (t < 16) continue; dst = p.out + O_YP + ((size_t)b * 2048 + (t - 16)) * DM; }
        else dst = p.out + O_YS + (size_t)(row - MP) * DM;
        const float rs = row_rs(rowss, row);
#pragma unroll
        for (int i = 0; i < 4; ++i) {
            const int c = i * 256 + lane * 4;
            const f32x4 v = *(const f32x4*)(H + (size_t)row * DM + c);
            const f32x4 g = *(const f32x4*)(p.ln_f + c);
            *(f32x4*)(dst + c) = v * rs * g;
        }
    }
}

__global__ void __launch_bounds__(NTHR, 2) hymba_fwd(Params p) {
    extern __shared__ __attribute__((aligned(16))) unsigned char lds_raw[];
    LAS unsigned char* lds = (LAS unsigned char*)lds_raw;
    cg::grid_group grid = cg::this_grid();
    float* H = (float*)(p.ws + OFF_H);
    bf16_t* Hb = (bf16_t*)(p.ws + OFF_HB);
    float* rowss = (float*)(p.ws + OFF_RS);
    const float* rope = (const float*)(p.ws + OFF_ROPE);
    bf16_t* Q = (bf16_t*)(p.ws + OFF_OV + OV_Q);
    bf16_t* Kb = (bf16_t*)(p.ws + OFF_OV + OV_K);
    bf16_t* Vb = (bf16_t*)(p.ws + OFF_OV + OV_V);
    bf16_t* U = (bf16_t*)(p.ws + OFF_OV + OV_U);
    bf16_t* MIX = (bf16_t*)(p.ws + OFF_OV + OV_MIX);
    bf16_t* ACT = (bf16_t*)(p.ws + OFF_OV);
    StaticOrder S;

#ifndef SK_PRO
    prologue(p, lds);
#endif
    grid.sync();
#pragma unroll 1
    for (int l = 0; l < 2; ++l) {
#ifndef SK_P1
        { EpiIn e{rowss, rope, Q, Kb, Vb, U, p.out, l}; S.init(MT, INW, gridDim.x, blockIdx.x); gemm_phase(lds, Gemm{Hb, wt_in(p.ws, l), MT, INW, DM}, S, e); }
#endif
        grid.sync();
#ifndef SK_MIX
        mixer_phase(p, l, lds);
#endif
        grid.sync();
#ifndef SK_P3
        { EpiRes e{H, Hb, rowss}; S.init(MT, DM, gridDim.x, blockIdx.x); gemm_phase(lds, Gemm{MIX, wt_out(p.ws, l), MT, DM, DM}, S, e); }
#endif
        grid.sync();
#ifndef SK_P4
        { EpiUp e{rowss, ACT}; S.init(MT, DFF, gridDim.x, blockIdx.x); gemm_phase(lds, Gemm{Hb, wt_up(p.ws, l), MT, DFF, DM}, S, e); }
#endif
        grid.sync();
#ifndef SK_P5
        { EpiRes e{H, Hb, rowss}; S.init(MT, DM, gridDim.x, blockIdx.x); gemm_phase(lds, Gemm{ACT, wt_dn(p.ws, l), MT, DM, DFF}, S, e); }
#endif
        grid.sync();
    }
    final_phase(p);
}

extern "C" void kernel_launch(void* const* d_in, const int* in_sizes, int n_in, void* d_out, int out_size, void* d_ws, size_t ws_size, hipStream_t stream) {
    if (ws_size < WS_NEED || (size_t)out_size != O_END || n_in != 16) {
        fprintf(stderr, "kernel_launch: unexpected sizes ws=%zu need=%zu out=%d need=%zu n_in=%d\n", ws_size, WS_NEED, out_size, O_END, n_in);
        return;
    }
    static int grid_blocks = 0;
    if (!grid_blocks) {
        int dev = 0, cus = 0, per_cu = 0;
        (void)hipGetDevice(&dev);
        (void)hipDeviceGetAttribute(&cus, hipDeviceAttributeMultiprocessorCount, dev);
        if (hipFuncSetAttribute((const void*)hymba_fwd, hipFuncAttributeMaxDynamicSharedMemorySize, LDS_BYTES) != hipSuccess) fprintf(stderr, "hipFuncSetAttribute failed\n");
        (void)hipOccupancyMaxActiveBlocksPerMultiprocessor(&per_cu, hymba_fwd, NTHR, LDS_BYTES);
        if (per_cu < 1) { fprintf(stderr, "occupancy query says %d\n", per_cu); per_cu = 1; }
        if (per_cu > 1) per_cu = 1;
        grid_blocks = cus * per_cu;
    }
    Params p{};
    p.x_prompt = (const float*)d_in[0]; p.x_sample = (const float*)d_in[1]; p.cache_k = (const float*)d_in[2]; p.cache_v = (const float*)d_in[3];
    p.state_pool = (const float*)d_in[4]; p.meta = (const float*)d_in[5]; p.ln1 = (const float*)d_in[6]; p.w_in = (const float*)d_in[7];
    p.sinks = (const float*)d_in[8]; p.pool_w = (const float*)d_in[9]; p.pool_scale = (const float*)d_in[10]; p.w_out = (const float*)d_in[11];
    p.ln2 = (const float*)d_in[12]; p.w_up = (const float*)d_in[13]; p.w_down = (const float*)d_in[14]; p.ln_f = (const float*)d_in[15];
    p.out = (float*)d_out; p.ws = (unsigned char*)d_ws;
    void* args[] = {&p};
    hipError_t e = hipLaunchCooperativeKernel((const void*)hymba_fwd, dim3(grid_blocks), dim3(NTHR), args, LDS_BYTES, stream);
    if (e != hipSuccess) fprintf(stderr, "cooperative launch failed: %s (grid %d)\n", hipGetErrorString(e), grid_blocks);
}
```

```cpp
#include <hip/hip_runtime.h>
#include <hip/hip_cooperative_groups.h>
#include <cstdio>
#include <cstdint>
namespace cg = cooperative_groups;

typedef unsigned short bf16_t;
typedef short bf16x8 __attribute__((ext_vector_type(8)));
typedef float f32x4 __attribute__((ext_vector_type(4)));
typedef unsigned u32x4 __attribute__((ext_vector_type(4)));
typedef unsigned u32x2 __attribute__((ext_vector_type(2)));
#define DEVI __device__ __forceinline__
#define LAS __attribute__((address_space(3)))

constexpr int DM = 1024, LP = 2064, NBATCH = 16, MP = NBATCH * LP  , DB = 128, DS = 8, MS = DB * DS  ;
constexpr int MT = MP + MS  , INW = 1280, DFF = 4096, NM = MT / 128  ;
constexpr int NROPE = LP + DS;
constexpr float EPS = 1e-5f;

constexpr size_t O_YP = 0;
constexpr size_t O_YS = O_YP + (size_t)16 * 2048 * 1024;
constexpr size_t O_NKP = O_YS + (size_t)128 * 8 * 1024;
constexpr size_t O_NVP = O_NKP + (size_t)2 * 16 * 128 * 128;
constexpr size_t O_NPP = O_NVP + (size_t)2 * 16 * 128 * 128;
constexpr size_t O_NKS = O_NPP + (size_t)2 * 16 * 15 * 512;
constexpr size_t O_NVS = O_NKS + (size_t)2 * 128 * 128 * 128;
constexpr size_t O_NPS = O_NVS + (size_t)2 * 128 * 128 * 128;
constexpr size_t O_END = O_NPS + (size_t)2 * 128 * 15 * 512;

constexpr size_t WIN_E = (size_t)INW * DM, WOUT_E = (size_t)DM * DM, WUP_E = (size_t)DFF * DM, WDN_E = (size_t)DM * DFF;
constexpr size_t WL_E = WIN_E + WOUT_E + WUP_E + WDN_E;
constexpr size_t OFF_W = 0;
constexpr size_t OFF_H = OFF_W + 2 * WL_E * 2;
constexpr size_t OFF_HB = OFF_H + (size_t)MT * DM * 4;
constexpr size_t OFF_RS = OFF_HB + (size_t)MT * DM * 2;
constexpr size_t OFF_ROPE = OFF_RS + (size_t)MT * 16 * 4;
constexpr size_t OFF_BAR = OFF_ROPE + (size_t)NROPE * 16 * 4;
constexpr size_t BAR_BYTES = 3456 * 4;
constexpr size_t OFF_OV = OFF_BAR + BAR_BYTES;
constexpr size_t OV_Q = 0;
constexpr size_t OV_K = OV_Q + (size_t)MT * 512 * 2;
constexpr size_t OV_V = OV_K + (size_t)MT * 128 * 2;
constexpr size_t OV_U = OV_V + (size_t)MT * 128 * 2;
constexpr size_t OV_MIX = OV_U + (size_t)MT * 512 * 2;
constexpr size_t OV_END = OV_MIX + (size_t)MT * 1024 * 2;
constexpr size_t WS_NEED = OFF_OV + (size_t)MT * DFF * 2;
static_assert(OV_END <= (size_t)MT * DFF * 2, "overlay");

constexpr int LDS_STAGE = 131072;
constexpr int LDS_BYTES = LDS_STAGE + 16;
constexpr int NTHR = 512;

struct Params {
    const float *x_prompt, *x_sample, *cache_k, *cache_v, *state_pool, *meta, *ln1, *w_in, *sinks, *pool_w, *pool_scale, *w_out, *ln2, *w_up, *w_down, *ln_f;
    float* out;
    unsigned char* ws;
};

DEVI unsigned pk_bf16(float lo, float hi) { unsigned r; asm("v_cvt_pk_bf16_f32 %0, %1, %2" : "=v"(r) : "v"(lo), "v"(hi)); return r; }
DEVI float bf_lo(unsigned w) { return __uint_as_float(w << 16); }
DEVI float bf_hi(unsigned w) { return __uint_as_float(w & 0xffff0000u); }
DEVI int opaque_tid() { int t = threadIdx.x; asm volatile("" : "+v"(t)); return t; }
DEVI u32x2 pk4(f32x4 v) { u32x2 r; r.x = pk_bf16(v[0], v[1]); r.y = pk_bf16(v[2], v[3]); return r; }

constexpr int BM = 256, BK = 64, HALF = 128, HTB = HALF * BK * 2, NXCD = 8, WGM = 8;
DEVI int lds_byte(int r, int c) { const int st = (r >> 4) * 2 + (c >> 5), rr = r & 15, cc = c & 31, ob = rr * 64 + cc * 2; return st * 1024 + (ob ^ (((ob >> 9) & 1) << 5)); }
DEVI void stage_rc(int b, int& R, int& C) { const int st = b / 1024, sb = b % 1024, swz = sb ^ (((sb >> 9) & 1) << 5); R = (st >> 1) * 16 + swz / 64; C = (st & 1) * 32 + (swz % 64) / 2; }
DEVI int perm32(int rho) { const int n = rho >> 4, i = rho & 15; return 8 * (i >> 2) + 4 * n + (i & 3); }
struct Unit { int pm, pn; };
struct Gemm { const bf16_t* A; const bf16_t* Bt; int M, N, K; };
struct StaticOrder {
    int nM, nN, nwg, G, c;
    DEVI void init(int M, int N, int G_, int c_) { nM = M / BM; nN = N / BM; nwg = nM * nN; G = G_; c = c_; }
    DEVI bool next(int i, Unit& u) const {
        const long L = (long)i * G + c; if (L >= nwg) return false;
        int wgid = (int)L; { const int q = nwg / NXCD, r = nwg % NXCD, xcd = wgid % NXCD, off = wgid / NXCD; wgid = (xcd < r ? xcd * (q + 1) : r * (q + 1) + (xcd - r) * q) + off; }
        const int nig = WGM * nN, gid = wgid / nig, fm = gid * WGM, gsz = (nM - fm) < WGM ? (nM - fm) : WGM;
        u.pm = fm + ((wgid % nig) % gsz); u.pn = (wgid % nig) / gsz; return true;
    }
};
template <class Epi>
DEVI void gemm_phase(LAS unsigned char* lds, const Gemm g, const StaticOrder& S, const Epi& E) {
    const int tid = opaque_tid(), wid = __builtin_amdgcn_readfirstlane(tid >> 6), lane = tid & 63, wr = wid >> 2, wc = wid & 3, fr = lane & 15, fq = lane >> 4;
    const int K = g.K, nt = K / BK;
    unsigned voffA[2], voffB[2];
#pragma unroll
    for (int i = 0; i < 2; ++i) { int R, C; stage_rc(tid * 16 + i * 8192, R, C); const int Rb = (R & ~31) + perm32(R & 31);
        voffA[i] = (unsigned)(R * K + C) * 2u; voffB[i] = (unsigned)(Rb * K + C) * 2u; }
    const size_t kstep = (size_t)(BK * 2);
    const size_t hstep = (size_t)HALF * K * 2;
    const size_t tstep = 2 * hstep;
    const unsigned ldsw = (unsigned)wid * 1024u;
    const int aoff = lds_byte(wr * 64 + fr, fq * 8), boff = lds_byte(wc * 32 + fr, fq * 8);
#define PG8_SA(b, h) (((b) * 2 + (h)) * HTB)
#define PG8_SB(b, h) ((4 + (b) * 2 + (h)) * HTB)
#define PG8_STAGE(bufoff, gbase, voff) do { _Pragma("unroll") for (int _i = 0; _i < 2; ++_i) \
        __builtin_amdgcn_global_load_lds((const unsigned*)((const char*)(gbase) + (voff)[_i]), (LAS unsigned*)(lds + (bufoff) + ldsw + _i * 8192), 16, 0, 0); } while (0)
#define PG8_LDA(dst, b, h) do { _Pragma("unroll") for (int m = 0; m < 4; ++m) _Pragma("unroll") for (int k = 0; k < 2; ++k) dst[m][k] = *(const LAS bf16x8*)(lds + PG8_SA(b, h) + aoff + m * 2048 + k * 1024); } while (0)
#define PG8_LDB(dst, b, h) do { _Pragma("unroll") for (int n = 0; n < 2; ++n) _Pragma("unroll") for (int k = 0; k < 2; ++k) dst[n][k] = *(const LAS bf16x8*)(lds + PG8_SB(b, h) + boff + n * 2048 + k * 1024); } while (0)
#define PG8_MMA(ai, bj, At, Bt) do { __builtin_amdgcn_s_setprio(1); _Pragma("unroll") for (int m = 0; m < 4; ++m) _Pragma("unroll") for (int n = 0; n < 2; ++n) _Pragma("unroll") for (int k = 0; k < 2; ++k) \
        acc[ai][bj][m][n] = __builtin_amdgcn_mfma_f32_16x16x32_bf16(Bt[n][k], At[m][k], acc[ai][bj][m][n], 0, 0, 0); __builtin_amdgcn_s_setprio(0); } while (0)
#define PG8_WAIT_V(n) asm volatile("s_waitcnt vmcnt(" #n ")" ::: "memory")
#define PG8_WAIT_L(n) asm volatile("s_waitcnt lgkmcnt(" #n ")" ::: "memory")
#define PG8_BAR __builtin_amdgcn_s_barrier()
#define PG8_SCHED __builtin_amdgcn_sched_barrier(0)
    Unit cur, nxt; int ui = 0;
    if (!S.next(0, cur)) return;
    f32x4 acc[2][2][4][2];
#pragma unroll
    for (int a = 0; a < 2; ++a)
#pragma unroll
        for (int b = 0; b < 2; ++b)
#pragma unroll
            for (int m = 0; m < 4; ++m)
#pragma unroll
                for (int n = 0; n < 2; ++n) acc[a][b][m][n] = (f32x4){0.f, 0.f, 0.f, 0.f};
    bf16x8 At[4][2], B0[2][2], B1[2][2];
    const char* cA = (const char*)g.A + (size_t)cur.pm * tstep; const char* cB = (const char*)g.Bt + (size_t)cur.pn * tstep;
    PG8_STAGE(PG8_SB(0, 0), cB, voffB); PG8_STAGE(PG8_SA(0, 0), cA, voffA); PG8_STAGE(PG8_SB(0, 1), cB + hstep, voffB); PG8_STAGE(PG8_SA(0, 1), cA + hstep, voffA);
    if (wr == 1) PG8_BAR;
    PG8_WAIT_V(4); PG8_BAR;
    PG8_STAGE(PG8_SB(1, 0), cB + kstep, voffB); PG8_STAGE(PG8_SA(1, 0), cA + kstep, voffA); PG8_STAGE(PG8_SB(1, 1), cB + hstep + kstep, voffB);
    PG8_WAIT_V(6); PG8_BAR;
    for (;;) {
        const bool has_next = S.next(ui + 1, nxt);
        const char* nA = has_next ? (const char*)g.A + (size_t)nxt.pm * tstep : cA; const char* nB = has_next ? (const char*)g.Bt + (size_t)nxt.pn * tstep : cB;
        for (int t = 0; t < nt; t += 2) {
            const bool last = (t == nt - 2);
            const char* a1 = cA + (size_t)(t + 1) * kstep;
            const char* a2 = last ? nA : cA + (size_t)(t + 2) * kstep; const char* b2 = last ? nB : cB + (size_t)(t + 2) * kstep;
            const char* a3 = a2 + kstep; const char* b3 = b2 + kstep;
            PG8_LDB(B0, 0, 0); PG8_SCHED; PG8_LDA(At, 0, 0); PG8_STAGE(PG8_SA(1, 1), a1 + hstep, voffA);
            PG8_WAIT_L(8); PG8_BAR; PG8_WAIT_L(0); PG8_MMA(0, 0, At, B0); PG8_BAR; PG8_SCHED;
            PG8_LDB(B1, 0, 1); PG8_STAGE(PG8_SB(0, 0), b2, voffB);
            PG8_BAR; PG8_WAIT_L(0); PG8_MMA(0, 1, At, B1); PG8_BAR;
            PG8_LDA(At, 0, 1); PG8_STAGE(PG8_SA(0, 0), a2, voffA);
            PG8_BAR; PG8_WAIT_L(0); PG8_MMA(1, 0, At, B0); PG8_BAR; PG8_SCHED;
            PG8_STAGE(PG8_SB(0, 1), b2 + hstep, voffB);
            PG8_WAIT_V(6); PG8_BAR; PG8_MMA(1, 1, At, B1); PG8_BAR;
            PG8_LDB(B0, 1, 0); PG8_SCHED; PG8_LDA(At, 1, 0); PG8_STAGE(PG8_SA(0, 1), a2 + hstep, voffA);
            PG8_WAIT_L(8); PG8_BAR; PG8_WAIT_L(0); PG8_MMA(0, 0, At, B0); PG8_BAR; PG8_SCHED;
            PG8_LDB(B1, 1, 1); PG8_STAGE(PG8_SB(1, 0), b3, voffB);
            PG8_BAR; PG8_WAIT_L(0); PG8_MMA(0, 1, At, B1); PG8_BAR;
            PG8_LDA(At, 1, 1); PG8_STAGE(PG8_SA(1, 0), a3, voffA);
            PG8_BAR; PG8_WAIT_L(0); PG8_MMA(1, 0, At, B0); PG8_BAR; PG8_SCHED;
            PG8_STAGE(PG8_SB(1, 1), b3 + hstep, voffB);
            PG8_WAIT_V(6); PG8_BAR; PG8_MMA(1, 1, At, B1); PG8_BAR;
        }
        E(acc, cur, wr, wc, fr, fq);
        if (!has_next) break;
#pragma unroll
        for (int a = 0; a < 2; ++a)
#pragma unroll
            for (int b = 0; b < 2; ++b)
#pragma unroll
                for (int m = 0; m < 4; ++m)
#pragma unroll
                    for (int n = 0; n < 2; ++n) acc[a][b][m][n] = (f32x4){0.f, 0.f, 0.f, 0.f};
        cur = nxt; cA = nA; cB = nB; ++ui;
    }
    PG8_WAIT_V(0);
    if (wr == 0) PG8_BAR;
    PG8_BAR;
#undef PG8_SA
#undef PG8_SB
#undef PG8_STAGE
#undef PG8_LDA
#undef PG8_LDB
#undef PG8_MMA
#undef PG8_WAIT_V
#undef PG8_WAIT_L
#undef PG8_BAR
#undef PG8_SCHED
}

DEVI float row_rs(const float* rowss, int row) {
    const f32x4* rp = (const f32x4*)(rowss + (size_t)row * 16);
    const f32x4 a = (rp[0] + rp[1]) + (rp[2] + rp[3]);
    const float ss = (a[0] + a[1]) + (a[2] + a[3]);
    return rsqrtf(ss * (1.f / 1024.f) + EPS);
}
DEVI float row_rs4(const float* rowss, int row, int fq) {
    const f32x4 a = *(const f32x4*)(rowss + (size_t)row * 16 + fq * 4);
    float ss = (a[0] + a[1]) + (a[2] + a[3]);
    ss += __shfl_xor(ss, 16);
    ss += __shfl_xor(ss, 32);
    return rsqrtf(ss * (1.f / 1024.f) + EPS);
}
DEVI u32x4 pk8(f32x4 a, f32x4 b) { u32x4 r; r.x = pk_bf16(a[0], a[1]); r.y = pk_bf16(a[2], a[3]); r.z = pk_bf16(b[0], b[1]); r.w = pk_bf16(b[2], b[3]); return r; }

struct EpiIn {
    const float* rowss; const float* rope; bf16_t *Q, *Kb, *Vb, *U; float* out; int l;
    DEVI void operator()(const f32x4 (&acc)[2][2][4][2], const Unit& u, int wr, int wc, int fr, int fq) const {
#pragma unroll
        for (int ai = 0; ai < 2; ++ai)
#pragma unroll
            for (int m = 0; m < 4; ++m) {
                const int row = u.pm * 256 + ai * 128 + wr * 64 + m * 16 + fr;
                const float rs = row_rs4(rowss, row, fq);
                const bool samp = row >= MP;
                int b, t;
                if (!samp) { b = row / LP; t = row - b * LP; } else { const int r = row - MP; b = r >> 3; t = r & 7; }
                const int pidx = samp ? LP + t : t;
#pragma unroll
                for (int bj = 0; bj < 2; ++bj) {
                    const int cb = u.pn * 256 + bj * 128 + wc * 32;
                    f32x4 v0 = acc[ai][bj][m][0] * rs, v1 = acc[ai][bj][m][1] * rs;
                    if (cb < 640 && (wc & 1) == 0) {
                        const f32x4 c0 = *(const f32x4*)(rope + pidx * 16), c1 = *(const f32x4*)(rope + pidx * 16 + 4);
                        const f32x4 s0 = *(const f32x4*)(rope + pidx * 16 + 8), s1 = *(const f32x4*)(rope + pidx * 16 + 12);
                        f32x4 p0, p1;
#pragma unroll
                        for (int jj = 0; jj < 4; ++jj) { p0[jj] = __shfl_xor(v0[jj], 16); p1[jj] = __shfl_xor(v1[jj], 16); }
                        if (fq < 2) {
                            const float sg = fq == 0 ? -1.f : 1.f;
                            v0 = v0 * c0 + p0 * s0 * sg; v1 = v1 * c1 + p1 * s1 * sg;
                        }
                    }
                    if (cb < 512) {
                        *(u32x4*)(Q + (size_t)row * 512 + cb + 8 * fq) = pk8(v0 * 0.125f, v1 * 0.125f);
                    } else if (cb < 768) {
                        const bool isk = cb < 640;
                        const int kc = (isk ? cb - 512 : cb - 640) + 8 * fq;
                        *(u32x4*)((isk ? Kb : Vb) + (size_t)row * 128 + kc) = pk8(v0, v1);
                        float* dst = nullptr;
                        if (!samp) { if (t >= LP - 128) dst = out + (isk ? O_NKP : O_NVP) + ((size_t)((l * 16 + b) * 128 + (t - (LP - 128)))) * 128; }
                        else dst = out + (isk ? O_NKS : O_NVS) + ((size_t)((l * 128 + b) * 128 + 120 + t)) * 128;
                        if (dst) { *(f32x4*)(dst + kc) = v0; *(f32x4*)(dst + kc + 4) = v1; }
                    } else {
                        const int uc = cb - 768 + 8 * fq;
                        *(u32x4*)(U + (size_t)row * 512 + uc) = pk8(v0, v1);
                        float* dst = nullptr;
                        if (!samp) { if (t >= LP - 15) dst = out + O_NPP + ((size_t)((l * 16 + b) * 15 + (t - (LP - 15)))) * 512; }
                        else dst = out + O_NPS + ((size_t)((l * 128 + b) * 15 + 7 + t)) * 512;
                        if (dst) { *(f32x4*)(dst + uc) = v0; *(f32x4*)(dst + uc + 4) = v1; }
                    }
                }
            }
    }
};

struct EpiRes {
    float* H; bf16_t* Hb; float* rowss;
    DEVI void operator()(const f32x4 (&acc)[2][2][4][2], const Unit& u, int wr, int wc, int fr, int fq) const {
#pragma unroll
        for (int ai = 0; ai < 2; ++ai)
#pragma unroll
            for (int m = 0; m < 4; ++m) {
                const int row = u.pm * 256 + ai * 128 + wr * 64 + m * 16 + fr;
                float ss = 0.f;
#pragma unroll
                for (int bj = 0; bj < 2; ++bj) {
                    const size_t o = (size_t)row * DM + u.pn * 256 + bj * 128 + wc * 32 + 8 * fq;
                    f32x4 h0 = *(const f32x4*)(H + o), h1 = *(const f32x4*)(H + o + 4);
                    h0 = h0 + acc[ai][bj][m][0]; h1 = h1 + acc[ai][bj][m][1];
                    *(f32x4*)(H + o) = h0; *(f32x4*)(H + o + 4) = h1;
                    *(u32x4*)(Hb + o) = pk8(h0, h1);
                    ss += ((h0[0] * h0[0] + h0[1] * h0[1]) + (h0[2] * h0[2] + h0[3] * h0[3])) + ((h1[0] * h1[0] + h1[1] * h1[1]) + (h1[2] * h1[2] + h1[3] * h1[3]));
                }
                ss += __shfl_xor(ss, 16);
                ss += __shfl_xor(ss, 32);
                if (fq == 0) rowss[(size_t)row * 16 + u.pn * 4 + wc] = ss;
                if (m & 1) __builtin_amdgcn_sched_barrier(0);
            }
    }
};

struct EpiUp {
    const float* rowss; bf16_t* ACT;
    DEVI void operator()(const f32x4 (&acc)[2][2][4][2], const Unit& u, int wr, int wc, int fr, int fq) const {
#pragma unroll
        for (int ai = 0; ai < 2; ++ai)
#pragma unroll
            for (int m = 0; m < 4; ++m) {
                const int row = u.pm * 256 + ai * 128 + wr * 64 + m * 16 + fr;
                const float rs = row_rs4(rowss, row, fq);
#pragma unroll
                for (int bj = 0; bj < 2; ++bj) {
                    f32x4 a0 = acc[ai][bj][m][0] * rs, a1 = acc[ai][bj][m][1] * rs;
#pragma unroll
                    for (int e = 0; e < 4; ++e) { const float x = fmaxf(a0[e], 0.f); a0[e] = x * x; const float y = fmaxf(a1[e], 0.f); a1[e] = y * y; }
                    *(u32x4*)(ACT + (size_t)row * DFF + u.pn * 256 + bj * 128 + wc * 32 + 8 * fq) = pk8(a0, a1);
                }
            }
    }
};

DEVI void transpose_tile(const float* __restrict__ W, int N, const float* __restrict__ g, bf16_t* __restrict__ Wt, int ldk, int kt, int nt_, LAS float* t, int ltid) {
    __syncthreads();
    {
        const int ty = ltid >> 4, n4 = (ltid & 15) * 4;
#pragma unroll
        for (int i = 0; i < 4; ++i) {
            const int k = ty + 16 * i;
            f32x4 v = *(const f32x4*)(W + (size_t)(kt * 64 + k) * N + nt_ * 64 + n4);
            const float s = g ? g[kt * 64 + k] : 1.f;
            t[k * 65 + n4 + 0] = v[0] * s; t[k * 65 + n4 + 1] = v[1] * s; t[k * 65 + n4 + 2] = v[2] * s; t[k * 65 + n4 + 3] = v[3] * s;
        }
    }
    __syncthreads();
    {
        const int n = ltid >> 2, kq = (ltid & 3) * 16;
        u32x4 o0, o1;
        o0.x = pk_bf16(t[(kq + 0) * 65 + n], t[(kq + 1) * 65 + n]);   o0.y = pk_bf16(t[(kq + 2) * 65 + n], t[(kq + 3) * 65 + n]);
        o0.z = pk_bf16(t[(kq + 4) * 65 + n], t[(kq + 5) * 65 + n]);   o0.w = pk_bf16(t[(kq + 6) * 65 + n], t[(kq + 7) * 65 + n]);
        o1.x = pk_bf16(t[(kq + 8) * 65 + n], t[(kq + 9) * 65 + n]);   o1.y = pk_bf16(t[(kq + 10) * 65 + n], t[(kq + 11) * 65 + n]);
        o1.z = pk_bf16(t[(kq + 12) * 65 + n], t[(kq + 13) * 65 + n]); o1.w = pk_bf16(t[(kq + 14) * 65 + n], t[(kq + 15) * 65 + n]);
        bf16_t* d = Wt + (size_t)(nt_ * 64 + n) * ldk + kt * 64 + kq;
        *(u32x4*)d = o0; *(u32x4*)(d + 8) = o1;
    }
}

DEVI bf16_t* wt_in(unsigned char* ws, int l) { return (bf16_t*)(ws + OFF_W) + (size_t)l * WL_E; }
DEVI bf16_t* wt_out(unsigned char* ws, int l) { return wt_in(ws, l) + WIN_E; }
DEVI bf16_t* wt_up(unsigned char* ws, int l) { return wt_out(ws, l) + WOUT_E; }
DEVI bf16_t* wt_dn(unsigned char* ws, int l) { return wt_up(ws, l) + WUP_E; }

constexpr int U_TRL = (320 + 128 + 1024 + 1024) / 2;
constexpr int U_TR = 2 * U_TRL;
constexpr int U_WC = U_TR + 64;
constexpr int U_ROWS = U_WC + MT / 8;
constexpr int U_ROPE = U_ROWS + (NROPE * 8 + NTHR - 1) / NTHR;
constexpr int U_CK = U_ROPE + 256;
constexpr int U_CV = U_CK + 256;
constexpr int U_CP = U_CV + 256;

DEVI void prologue(const Params& p, LAS unsigned char* lds) {
    const int tid = opaque_tid(), lane = tid & 63, wid = tid >> 6, sb = tid >> 8, ltid = tid & 255;
    float* H = (float*)(p.ws + OFF_H);
    bf16_t* Hb = (bf16_t*)(p.ws + OFF_HB);
    float* rowss = (float*)(p.ws + OFF_RS);
    float* rope = (float*)(p.ws + OFF_ROPE);
    LAS float* tl = (LAS float*)(lds + sb * 16640);
    for (int u = blockIdx.x; u < U_CP; u += gridDim.x) {
        if (u < U_TR) {
            const int l = u / U_TRL; int r = (u - l * U_TRL) * 2 + sb;
            if (r < 320) { transpose_tile(p.w_in + (size_t)l * DM * INW, INW, p.ln1 + l * DM, wt_in(p.ws, l), DM, r & 15, r >> 4, tl, ltid); }
            else if ((r -= 320) < 128) { transpose_tile(p.w_out + (size_t)l * DM * DM, DM, nullptr, wt_out(p.ws, l), DM, r & 7, r >> 3, tl, ltid); }
            else if ((r -= 128) < 1024) { transpose_tile(p.w_up + (size_t)l * DM * DFF, DFF, p.ln2 + l * DM, wt_up(p.ws, l), DM, r & 15, r >> 4, tl, ltid); }
            else { r -= 1024; transpose_tile(p.w_down + (size_t)l * DFF * DM, DM, nullptr, wt_dn(p.ws, l), DFF, r & 63, r >> 6, tl, ltid); }
        } else if (u < U_WC) {
            const int r = u - U_TR, l = r >> 5, g = (r >> 3) & 3, n = (r & 7) * 128 + (wid >> 2) * 64 + lane, c0 = (wid & 3) * 32;
            const float* pw = p.pool_w + ((size_t)(l * 4 + g) * 128 + c0) * 128;
            const float* sc = p.pool_scale + l * 512 + g * 128;
            const float* wo = p.w_out + (size_t)l * DM * DM + (size_t)(512 + g * 128) * DM + n;
            float acc[32];
#pragma unroll
            for (int c = 0; c < 32; ++c) acc[c] = 0.f;
            for (int e = 0; e < 128; ++e) {
                const float w = wo[(size_t)e * DM] * sc[e];
#pragma unroll
                for (int c = 0; c < 32; ++c) acc[c] += pw[c * 128 + e] * w;
            }
            bf16_t* d = wt_out(p.ws, l) + (size_t)n * DM + 512 + g * 128 + c0;
#pragma unroll
            for (int c = 0; c < 32; c += 8) {
                u32x4 o; o.x = pk_bf16(acc[c], acc[c + 1]); o.y = pk_bf16(acc[c + 2], acc[c + 3]); o.z = pk_bf16(acc[c + 4], acc[c + 5]); o.w = pk_bf16(acc[c + 6], acc[c + 7]);
                *(u32x4*)(d + c) = o;
            }
        } else if (u < U_ROWS) {
            const int row = (u - U_WC) * 8 + wid;
            const float* src;
            if (row < MP) { const int b = row / LP, t = row - b * LP; src = t < 16 ? p.meta + (size_t)t * DM : p.x_prompt + ((size_t)b * 2048 + (t - 16)) * DM; }
            else src = p.x_sample + (size_t)(row - MP) * DM;
            float ss = 0.f;
#pragma unroll
            for (int i = 0; i < 4; ++i) {
                const int c = i * 256 + lane * 4;
                const f32x4 v = *(const f32x4*)(src + c);
                *(f32x4*)(H + (size_t)row * DM + c) = v;
                *(u32x2*)(Hb + (size_t)row * DM + c) = pk4(v);
                ss += (v[0] * v[0] + v[1] * v[1]) + (v[2] * v[2] + v[3] * v[3]);
            }
#pragma unroll
            for (int o = 32; o >= 1; o >>= 1) ss += __shfl_xor(ss, o);
            if (lane < 16) rowss[(size_t)row * 16 + lane] = lane == 0 ? ss : 0.f;
        } else if (u < U_ROPE) {
            const int id = (u - U_ROWS) * NTHR + tid;
            if (id < NROPE * 8) {
                const int idx = id >> 3, i = id & 7;
                const int pos = idx < LP ? idx : 16384 + (idx - LP);
                const float inv = exp2f(-(float)i * 0.125f * 18.931568569324174f);
                const float ang = (float)pos * inv;
                double rev = (double)ang * 0.15915494309189535;
                rev -= rint(rev);
                const float red = (float)(rev * 6.283185307179586);
                rope[idx * 16 + i] = __cosf(red);
                rope[idx * 16 + 8 + i] = __sinf(red);
            }
        } else if (u < U_CV) {
            const bool isk = u < U_CK;
            const int r = isk ? u - U_ROPE : u - U_CK;
            const f32x4* src = (const f32x4*)((isk ? p.cache_k : p.cache_v) + (size_t)r * 128 * 128 + 8 * 128);
            f32x4* dst = (f32x4*)(p.out + (isk ? O_NKS : O_NVS) + (size_t)r * 128 * 128);
            for (int i = tid; i < 120 * 32; i += NTHR) dst[i] = src[i];
        } else {
            const int r = u - U_CV;
            const f32x4* src = (const f32x4*)(p.state_pool + (size_t)r * 15 * 512 + 8 * 512);
            f32x4* dst = (f32x4*)(p.out + O_NPS + (size_t)r * 15 * 512);
            for (int i = tid; i < 7 * 128; i += NTHR) dst[i] = src[i];
        }
    }
    __syncthreads();
}

constexpr int N_PU = NBATCH * 65;
constexpr int N_AU = N_PU + DB;

DEVI void add8(f32x4& a0, f32x4& a1, const u32x4 w) {
    a0[0] += bf_lo(w.x); a0[1] += bf_hi(w.x); a0[2] += bf_lo(w.y); a0[3] += bf_hi(w.y);
    a1[0] += bf_lo(w.z); a1[1] += bf_hi(w.z); a1[2] += bf_lo(w.w); a1[3] += bf_hi(w.w);
}

DEVI void mixer_phase(const Params& p, const int l, LAS unsigned char* lds_all) {
    const int tid0 = opaque_tid(), tid = tid0 & 255, kvh = tid0 >> 8, lane = tid & 63, wid = tid >> 6, fr = lane & 15, fq = lane >> 4;
    const bf16_t* Q = (const bf16_t*)(p.ws + OFF_OV + OV_Q);
    const bf16_t* Kb = (const bf16_t*)(p.ws + OFF_OV + OV_K);
    const bf16_t* Vb = (const bf16_t*)(p.ws + OFF_OV + OV_V);
    const bf16_t* U = (const bf16_t*)(p.ws + OFF_OV + OV_U);
    bf16_t* MIX = (bf16_t*)(p.ws + OFF_OV + OV_MIX);
    LAS unsigned char* Ks = lds_all + kvh * 44544;
    LAS bf16_t* Vt = (LAS bf16_t*)(Ks + 160 * 144);
    for (int unit = blockIdx.x; unit < N_AU; unit += gridDim.x) {
        const bool samp = unit >= N_PU;
        int b, t0;
        if (!samp) { b = unit / 65; t0 = (unit - b * 65) * 32; }
        else { b = unit - N_PU; t0 = 0; }
        const int rowbase = samp ? MP + b * 8 : b * LP;

        if (!samp) {
#pragma unroll 1
            for (int i = 0; i < 4; ++i) {
                const int c = tid + 256 * i, ir = c >> 5, ch = kvh * 256 + (c & 31) * 8, g = ch >> 7, w = 2 << g, pos = t0 + ir;
                if (pos < LP) {
                    const int n = (pos + 1) < w ? (pos + 1) : w;
                    const bf16_t* up = U + (size_t)(rowbase + pos) * 512 + ch;
                    f32x4 a0 = {0.f, 0.f, 0.f, 0.f}, a1 = {0.f, 0.f, 0.f, 0.f}, u0 = a0, u1 = a0;
                    add8(u0, u1, *(const u32x4*)up);
                    for (int ii = 1; ii < n; ++ii) add8(a0, a1, *(const u32x4*)(up - (size_t)ii * 512));
                    const float inv = 1.f / (float)n;
                    a0 = (a0 + u0) * inv - u0; a1 = (a1 + u1) * inv - u1;
                    *(u32x4*)(MIX + (size_t)(rowbase + pos) * 1024 + 512 + ch) = pk8(a0, a1);
                }
            }
        } else {
            const int s = tid >> 5, ch = kvh * 256 + (tid & 31) * 8, g = ch >> 7, w = 2 << g;
            f32x4 a0 = {0.f, 0.f, 0.f, 0.f}, a1 = {0.f, 0.f, 0.f, 0.f}, u0 = a0, u1 = a0;
            add8(u0, u1, *(const u32x4*)(U + (size_t)(rowbase + s) * 512 + ch));
            for (int ii = 1; ii < w; ++ii) {
                const int r = s - ii;
                if (r >= 0) add8(a0, a1, *(const u32x4*)(U + (size_t)(rowbase + r) * 512 + ch));
                else { const float* sp = p.state_pool + ((size_t)(l * 128 + b) * 15 + (15 + r)) * 512 + ch; a0 = a0 + *(const f32x4*)sp; a1 = a1 + *(const f32x4*)(sp + 4); }
            }
            const float inv = 1.f / (float)w;
            a0 = (a0 + u0) * inv - u0; a1 = (a1 + u1) * inv - u1;
            *(u32x4*)(MIX + (size_t)(rowbase + s) * 1024 + 512 + ch) = pk8(a0, a1);
        }

        u32x4 kq[5], vq[5];
#pragma unroll
        for (int i = 0; i < 5; ++i) {
            const int c = tid + 256 * i, j = c >> 3, dc = c & 7;
            kq[i] = (u32x4){0u, 0u, 0u, 0u}; vq[i] = kq[i];
            if (!samp) {
                const int kpos = t0 - 128 + j;
                if (kpos >= 0 && kpos < LP) {
                    const size_t o = (size_t)(rowbase + kpos) * 128 + kvh * 64 + dc * 8;
                    kq[i] = *(const u32x4*)(Kb + o); vq[i] = *(const u32x4*)(Vb + o);
                }
            } else if (j < 128) {
                const size_t o = (((size_t)(l * 128 + b) * 128 + j) * 2 + kvh) * 64 + dc * 8;
                const f32x4 k0 = *(const f32x4*)(p.cache_k + o), k1 = *(const f32x4*)(p.cache_k + o + 4);
                const f32x4 v0 = *(const f32x4*)(p.cache_v + o), v1 = *(const f32x4*)(p.cache_v + o + 4);
                kq[i] = pk8(k0, k1); vq[i] = pk8(v0, v1);
            } else if (j < 136) {
                const size_t o = (size_t)(rowbase + j - 128) * 128 + kvh * 64 + dc * 8;
                kq[i] = *(const u32x4*)(Kb + o); vq[i] = *(const u32x4*)(Vb + o);
            }
        }
        const int h = kvh * 4 + wid;
        bf16x8 qf[2][2];
#pragma unroll
        for (int qt = 0; qt < 2; ++qt) {
            const int i = qt * 16 + fr;
            const bool ok = samp ? (i < 8) : (t0 + i < LP);
            const bf16_t* qp = Q + (size_t)(rowbase + (samp ? 0 : t0) + i) * 512 + h * 64 + fq * 8;
#pragma unroll
            for (int ks = 0; ks < 2; ++ks) {
                u32x4 w = {0u, 0u, 0u, 0u};
                if (ok) w = *(const u32x4*)(qp + ks * 32);
                qf[qt][ks] = __builtin_bit_cast(bf16x8, w);
            }
        }
        __syncthreads();
#pragma unroll
        for (int i = 0; i < 5; ++i) {
            const int c = tid + 256 * i, j = c >> 3, dc = c & 7;
            *(LAS u32x4*)(Ks + j * 144 + dc * 16) = kq[i];
            LAS bf16_t* vt = Vt + (dc * 8) * 168 + j;
            vt[0 * 168] = (bf16_t)(vq[i].x & 0xffff); vt[1 * 168] = (bf16_t)(vq[i].x >> 16);
            vt[2 * 168] = (bf16_t)(vq[i].y & 0xffff); vt[3 * 168] = (bf16_t)(vq[i].y >> 16);
            vt[4 * 168] = (bf16_t)(vq[i].z & 0xffff); vt[5 * 168] = (bf16_t)(vq[i].z >> 16);
            vt[6 * 168] = (bf16_t)(vq[i].w & 0xffff); vt[7 * 168] = (bf16_t)(vq[i].w >> 16);
        }
        __syncthreads();

        f32x4 s[2][10];
#pragma unroll
        for (int t = 0; t < 10; ++t) {
            const bf16x8 k0 = *(const LAS bf16x8*)(Ks + (16 * t + fr) * 144 + fq * 16);
            const bf16x8 k1 = *(const LAS bf16x8*)(Ks + (16 * t + fr) * 144 + 64 + fq * 16);
#pragma unroll
            for (int qt = 0; qt < 2; ++qt) {
                f32x4 z = {0.f, 0.f, 0.f, 0.f};
                z = __builtin_amdgcn_mfma_f32_16x16x32_bf16(k0, qf[qt][0], z, 0, 0, 0);
                s[qt][t] = __builtin_amdgcn_mfma_f32_16x16x32_bf16(k1, qf[qt][1], z, 0, 0, 0);
            }
        }
        const float sink = p.sinks[l * 8 + h];
        float inv[2];
#pragma unroll
        for (int qt = 0; qt < 2; ++qt) {
            const int i = qt * 16 + fr;
            float mx = -INFINITY;
#pragma unroll
            for (int t = 0; t < 10; ++t)
#pragma unroll
                for (int jj = 0; jj < 4; ++jj) {
                    const int j = 16 * t + 4 * fq + jj;
                    const bool ok = (j >= i) && (j <= i + 128) && (samp || (t0 - 128 + j >= 0));
                    const float x = ok ? s[qt][t][jj] : -INFINITY;
                    s[qt][t][jj] = x;
                    mx = fmaxf(mx, x);
                }
            mx = fmaxf(mx, __shfl_xor(mx, 16));
            mx = fmaxf(mx, __shfl_xor(mx, 32));
            const float m = fmaxf(mx, sink);
            float sum = 0.f;
#pragma unroll
            for (int t = 0; t < 10; ++t)
#pragma unroll
                for (int jj = 0; jj < 4; ++jj) { const float e = __expf(s[qt][t][jj] - m); s[qt][t][jj] = e; sum += e; }
            sum += __shfl_xor(sum, 16);
            sum += __shfl_xor(sum, 32);
            inv[qt] = 1.f / (sum + __expf(sink - m));
        }
        f32x4 o[2][4];
#pragma unroll
        for (int qt = 0; qt < 2; ++qt)
#pragma unroll
            for (int dt = 0; dt < 4; ++dt) o[qt][dt] = (f32x4){0.f, 0.f, 0.f, 0.f};
#pragma unroll
        for (int pp = 0; pp < 5; ++pp) {
            bf16x8 pf[2];
#pragma unroll
            for (int qt = 0; qt < 2; ++qt) pf[qt] = __builtin_bit_cast(bf16x8, pk8(s[qt][2 * pp], s[qt][2 * pp + 1]));
#pragma unroll
            for (int dt = 0; dt < 4; ++dt) {
                const LAS bf16_t* vp = Vt + (16 * dt + fr) * 168 + 32 * pp + 4 * fq;
                const u32x2 v0 = *(const LAS u32x2*)vp, v1 = *(const LAS u32x2*)(vp + 16);
                const u32x4 vw = {v0.x, v0.y, v1.x, v1.y};
                const bf16x8 vf = __builtin_bit_cast(bf16x8, vw);
#pragma unroll
                for (int qt = 0; qt < 2; ++qt) o[qt][dt] = __builtin_amdgcn_mfma_f32_16x16x32_bf16(vf, pf[qt], o[qt][dt], 0, 0, 0);
            }
        }
#pragma unroll
        for (int qt = 0; qt < 2; ++qt) {
            const int i = qt * 16 + fr;
            const bool ok = samp ? (i < 8) : (t0 + i < LP);
            if (ok) {
                bf16_t* op = MIX + (size_t)(rowbase + (samp ? 0 : t0) + i) * 1024 + h * 64 + 4 * fq;
#pragma unroll
                for (int dt = 0; dt < 4; ++dt) *(u32x2*)(op + 16 * dt) = pk4(o[qt][dt] * inv[qt]);
            }
        }
    }
    __syncthreads();
}

DEVI void final_phase(const Params& p) {
    const int tid = opaque_tid(), lane = tid & 63, wid = tid >> 6;
    const float* H = (const float*)(p.ws + OFF_H);
    const float* rowss = (const float*)(p.ws + OFF_RS);
    for (int u = blockIdx.x; u < MT / 8; u += gridDim.x) {
        const int row = u * 8 + wid;
        float* dst;
        if (row < MP) { const int b = row / LP, t = row - b * LP; if (t < 16) continue; dst = p.out + O_YP + ((size_t)b * 2048 + (t - 16)) * DM; }
        else dst = p.out + O_YS + (size_t)(row - MP) * DM;
        const float rs = row_rs(rowss, row);
#pragma unroll
        for (int i = 0; i < 4; ++i) {
            const int c = i * 256 + lane * 4;
            const f32x4 v = *(const f32x4*)(H + (size_t)row * DM + c);
            const f32x4 g = *(const f32x4*)(p.ln_f + c);
            *(f32x4*)(dst + c) = v * rs * g;
        }
    }
}

#define XB_TMO      128
#define XB_XCNT(j)  (256  + 64 * (j))
#define XB_XSUB(j)  (1280 + 64 * (j))
#define XB_XGEN(j)  (2304 + 64 * (j))
#define XB_TOP      3328
#define XB_TOPGEN   3392
#define XCD_BAR_WORDS 3456
#define XB_SPIN_CAP (1u << 18)
DEVI unsigned xb_ld(unsigned* p)              { return __hip_atomic_load(p, __ATOMIC_RELAXED, __HIP_MEMORY_SCOPE_AGENT); }
DEVI unsigned xb_add(unsigned* p, unsigned v) { return __hip_atomic_fetch_add(p, v, __ATOMIC_RELAXED, __HIP_MEMORY_SCOPE_AGENT); }
DEVI unsigned xb_xcc_id() { return (unsigned)__builtin_amdgcn_s_getreg((3 << 11) | 20) & 0xFu; }
#define XB_SPIN(cond, bar) do { unsigned _sp = 0; while (cond) { __builtin_amdgcn_s_sleep(1); \
    if ((++_sp & 255u) == 0u) { if (xb_ld(&(bar)[XB_TMO])) break; if (_sp > XB_SPIN_CAP) { atomicAdd(&(bar)[XB_TMO], 1u); break; } } } } while (0)
struct XcdBarrier { unsigned* bar; unsigned x; volatile LAS unsigned* st; };
DEVI XcdBarrier xcd_barrier_post(unsigned* bar, volatile LAS unsigned* st) {
    XcdBarrier b; b.bar = bar; b.x = xb_xcc_id(); b.st = st;
    if (threadIdx.x == 0) (void)xb_add(&bar[XB_XCNT(b.x)], 1u);
    return b;
}
DEVI void xcd_barrier_complete(unsigned* bar, unsigned x, unsigned& nloc, unsigned& nx) {
    const unsigned G = gridDim.x * gridDim.y * gridDim.z;
    unsigned sum, cnt, mine, sp = 0u;
    for (;;) {
        sum = 0u; cnt = 0u; mine = 0u;
#pragma unroll
        for (unsigned j = 0; j < 16; ++j) { const unsigned c = xb_ld(&bar[XB_XCNT(j)]); sum += c; cnt += (c > 0u) ? 1u : 0u; mine = (j == x) ? c : mine; }
        if (sum == G) break;
        __builtin_amdgcn_s_sleep(1);
        if ((++sp & 255u) == 0u) { if (xb_ld(&bar[XB_TMO])) break; if (sp > XB_SPIN_CAP) { atomicAdd(&bar[XB_TMO], 1u); break; } }
    }
    nloc = mine > 0u ? mine : 1u; nx = cnt > 0u ? cnt : 1u;
}
DEVI void xcd_barrier(const XcdBarrier& b) {
    asm volatile("s_waitcnt vmcnt(0)" ::: "memory");
    __syncthreads();
    if (threadIdx.x == 0) {
        unsigned* bar = b.bar;
        __builtin_amdgcn_s_waitcnt(0);
        unsigned nloc = b.st[0], nx = b.st[1];
        if (nloc == 0u) { xcd_barrier_complete(bar, b.x, nloc, nx); b.st[0] = nloc; b.st[1] = nx; }
        const unsigned old = xb_add(&bar[XB_XSUB(b.x)], 1u);
        const unsigned gen = old / nloc;
        if (old + 1u == (gen + 1u) * nloc) {
            __builtin_amdgcn_fence(__ATOMIC_RELEASE, "agent");
            asm volatile("s_waitcnt vmcnt(0)" ::: "memory");
            const unsigned og = xb_add(&bar[XB_TOP], 1u);
            const unsigned tg = og / nx;
            if (og + 1u == (tg + 1u) * nx) xb_add(&bar[XB_TOPGEN], 1u);
            else XB_SPIN(xb_ld(&bar[XB_TOPGEN]) == tg, bar);
            __builtin_amdgcn_fence(__ATOMIC_ACQUIRE, "agent");
            xb_add(&bar[XB_XGEN(b.x)], 1u);
            asm volatile("s_waitcnt vmcnt(0)" ::: "memory");
        } else {
            XB_SPIN(xb_ld(&bar[XB_XGEN(b.x)]) == gen, bar);
            __builtin_amdgcn_fence(__ATOMIC_ACQUIRE, "agent");
            asm volatile("s_waitcnt vmcnt(0)" ::: "memory");
        }
    }
    __syncthreads();
}

__global__ void __launch_bounds__(NTHR, 2) hymba_fwd(Params p) {
    extern __shared__ __attribute__((aligned(16))) unsigned char lds_raw[];
    LAS unsigned char* lds = (LAS unsigned char*)lds_raw;
    cg::grid_group grid = cg::this_grid();
    float* H = (float*)(p.ws + OFF_H);
    bf16_t* Hb = (bf16_t*)(p.ws + OFF_HB);
    float* rowss = (float*)(p.ws + OFF_RS);
    const float* rope = (const float*)(p.ws + OFF_ROPE);
    bf16_t* Q = (bf16_t*)(p.ws + OFF_OV + OV_Q);
    bf16_t* Kb = (bf16_t*)(p.ws + OFF_OV + OV_K);
    bf16_t* Vb = (bf16_t*)(p.ws + OFF_OV + OV_V);
    bf16_t* U = (bf16_t*)(p.ws + OFF_OV + OV_U);
    bf16_t* MIX = (bf16_t*)(p.ws + OFF_OV + OV_MIX);
    bf16_t* ACT = (bf16_t*)(p.ws + OFF_OV);
    StaticOrder S;
    if (threadIdx.x < 4) ((LAS unsigned*)(lds + LDS_STAGE))[threadIdx.x] = 0u;
    __syncthreads();
    const XcdBarrier xb = xcd_barrier_post((unsigned*)(p.ws + OFF_BAR), (volatile LAS unsigned*)(lds + LDS_STAGE));

#ifndef SK_PRO
    prologue(p, lds);
#endif
#ifdef PROBE_PRO
    grid.sync();
    prologue(p, lds);
#endif
#ifdef PROBE_SYNC
    for (int i = 0; i < 10; ++i) grid.sync();
#endif
    grid.sync();
#pragma unroll 1
    for (int l = 0; l < 2; ++l) {
#ifndef SK_P1
        { EpiIn e{rowss, rope, Q, Kb, Vb, U, p.out, l}; S.init(MT, INW, gridDim.x, blockIdx.x); gemm_phase(lds, Gemm{Hb, wt_in(p.ws, l), MT, INW, DM}, S, e); }
#endif
        xcd_barrier(xb);
#ifndef SK_MIX
        mixer_phase(p, l, lds);
#endif
#ifdef PROBE_MIX
        xcd_barrier(xb);
        mixer_phase(p, l, lds);
#endif
        xcd_barrier(xb);
#ifndef SK_P3
        { EpiRes e{H, Hb, rowss}; S.init(MT, DM, gridDim.x, blockIdx.x); gemm_phase(lds, Gemm{MIX, wt_out(p.ws, l), MT, DM, DM}, S, e); }
#endif
        xcd_barrier(xb);
#ifndef SK_P4
        { EpiUp e{rowss, ACT}; S.init(MT, DFF, gridDim.x, blockIdx.x); gemm_phase(lds, Gemm{Hb, wt_up(p.ws, l), MT, DFF, DM}, S, e); }
#endif
        xcd_barrier(xb);
#ifndef SK_P5
        { EpiRes e{H, Hb, rowss}; S.init(MT, DM, gridDim.x, blockIdx.x); gemm_phase(lds, Gemm{ACT, wt_dn(p.ws, l), MT, DM, DFF}, S, e); }
#endif
        xcd_barrier(xb);
    }
    final_phase(p);
}

extern "C" void kernel_launch(void* const* d_in, const int* in_sizes, int n_in, void* d_out, int out_size, void* d_ws, size_t ws_size, hipStream_t stream) {
    if (ws_size < WS_NEED || (size_t)out_size != O_END || n_in != 16) {
        fprintf(stderr, "kernel_launch: unexpected sizes ws=%zu need=%zu out=%d need=%zu n_in=%d\n", ws_size, WS_NEED, out_size, O_END, n_in);
        return;
    }
    static int grid_blocks = 0;
    if (!grid_blocks) {
        int dev = 0, cus = 0, per_cu = 0;
        (void)hipGetDevice(&dev);
        (void)hipDeviceGetAttribute(&cus, hipDeviceAttributeMultiprocessorCount, dev);
        if (hipFuncSetAttribute((const void*)hymba_fwd, hipFuncAttributeMaxDynamicSharedMemorySize, LDS_BYTES) != hipSuccess) fprintf(stderr, "hipFuncSetAttribute failed\n");
        (void)hipOccupancyMaxActiveBlocksPerMultiprocessor(&per_cu, hymba_fwd, NTHR, LDS_BYTES);
        if (per_cu < 1) { fprintf(stderr, "occupancy query says %d\n", per_cu); per_cu = 1; }
        if (per_cu > 1) per_cu = 1;
        grid_blocks = cus * per_cu;
    }
    Params p{};
    p.x_prompt = (const float*)d_in[0]; p.x_sample = (const float*)d_in[1]; p.cache_k = (const float*)d_in[2]; p.cache_v = (const float*)d_in[3];
    p.state_pool = (const float*)d_in[4]; p.meta = (const float*)d_in[5]; p.ln1 = (const float*)d_in[6]; p.w_in = (const float*)d_in[7];
    p.sinks = (const float*)d_in[8]; p.pool_w = (const float*)d_in[9]; p.pool_scale = (const float*)d_in[10]; p.w_out = (const float*)d_in[11];
    p.ln2 = (const float*)d_in[12]; p.w_up = (const float*)d_in[13]; p.w_down = (const float*)d_in[14]; p.ln_f = (const float*)d_in[15];
    p.out = (float*)d_out; p.ws = (unsigned char*)d_ws;
    if (hipMemsetAsync((unsigned char*)d_ws + OFF_BAR, 0, BAR_BYTES, stream) != hipSuccess) fprintf(stderr, "memset failed\n");
    void* args[] = {&p};
    hipError_t e = hipLaunchCooperativeKernel((const void*)hymba_fwd, dim3(grid_blocks), dim3(NTHR), args, LDS_BYTES, stream);
    if (e != hipSuccess) fprintf(stderr, "cooperative launch failed: %s (grid %d)\n", hipGetErrorString(e), grid_blocks);
}
```

```cpp
#include <hip/hip_runtime.h>
#include <hip/hip_cooperative_groups.h>
#include <cstdio>
#include <cstdint>
namespace cg = cooperative_groups;

typedef unsigned short bf16_t;
typedef short bf16x8 __attribute__((ext_vector_type(8)));
typedef float f32x4 __attribute__((ext_vector_type(4)));
typedef unsigned u32x4 __attribute__((ext_vector_type(4)));
typedef unsigned u32x2 __attribute__((ext_vector_type(2)));
#define DEVI __device__ __forceinline__
#define LAS __attribute__((address_space(3)))

constexpr int DM = 1024, LP = 2064, NBATCH = 16, MP = NBATCH * LP  , DB = 128, DS = 8, MS = DB * DS  ;
constexpr int MT = MP + MS  , INW = 1280, DFF = 4096, NM = MT / 128  ;
constexpr int NROPE = LP + DS;
constexpr float EPS = 1e-5f;

constexpr size_t O_YP = 0;
constexpr size_t O_YS = O_YP + (size_t)16 * 2048 * 1024;
constexpr size_t O_NKP = O_YS + (size_t)128 * 8 * 1024;
constexpr size_t O_NVP = O_NKP + (size_t)2 * 16 * 128 * 128;
constexpr size_t O_NPP = O_NVP + (size_t)2 * 16 * 128 * 128;
constexpr size_t O_NKS = O_NPP + (size_t)2 * 16 * 15 * 512;
constexpr size_t O_NVS = O_NKS + (size_t)2 * 128 * 128 * 128;
constexpr size_t O_NPS = O_NVS + (size_t)2 * 128 * 128 * 128;
constexpr size_t O_END = O_NPS + (size_t)2 * 128 * 15 * 512;

constexpr size_t WIN_E = (size_t)INW * DM, WOUT_E = (size_t)DM * DM, WUP_E = (size_t)DFF * DM, WDN_E = (size_t)DM * DFF;
constexpr size_t WL_E = WIN_E + WOUT_E + WUP_E + WDN_E;
constexpr size_t OFF_W = 0;
constexpr size_t OFF_HB = OFF_W + 2 * WL_E * 2;
constexpr size_t OFF_RS = OFF_HB + (size_t)MT * DM * 2;
constexpr size_t OFF_ROPE = OFF_RS + (size_t)MT * 16 * 4;
constexpr size_t OFF_BAR = OFF_ROPE + (size_t)NROPE * 16 * 4;
constexpr size_t BAR_BYTES = 3456 * 4;
constexpr size_t OFF_OV = OFF_BAR + BAR_BYTES;
constexpr size_t OV_Q = 0;
constexpr size_t OV_K = OV_Q + (size_t)MT * 512 * 2;
constexpr size_t OV_V = OV_K + (size_t)MT * 128 * 2;
constexpr size_t OV_U = OV_V + (size_t)MT * 128 * 2;
constexpr size_t OV_MIX = OV_U + (size_t)MT * 512 * 2;
constexpr size_t OV_END = OV_MIX + (size_t)MT * 1024 * 2;
constexpr size_t WS_NEED = OFF_OV + (size_t)MT * DFF * 2;
static_assert(OV_END <= (size_t)MT * DFF * 2, "overlay");

constexpr int LDS_STAGE = 131072;
constexpr int LDS_BYTES = LDS_STAGE + 16;
constexpr int NTHR = 512;

struct Params {
    const float *x_prompt, *x_sample, *cache_k, *cache_v, *state_pool, *meta, *ln1, *w_in, *sinks, *pool_w, *pool_scale, *w_out, *ln2, *w_up, *w_down, *ln_f;
    float* out;
    unsigned char* ws;
};

DEVI unsigned pk_bf16(float lo, float hi) { unsigned r; asm("v_cvt_pk_bf16_f32 %0, %1, %2" : "=v"(r) : "v"(lo), "v"(hi)); return r; }
DEVI float bf_lo(unsigned w) { return __uint_as_float(w << 16); }
DEVI float bf_hi(unsigned w) { return __uint_as_float(w & 0xffff0000u); }
DEVI int opaque_tid() { int t = threadIdx.x; asm volatile("" : "+v"(t)); return t; }
DEVI u32x2 pk4(f32x4 v) { u32x2 r; r.x = pk_bf16(v[0], v[1]); r.y = pk_bf16(v[2], v[3]); return r; }

constexpr int BM = 256, BK = 64, HALF = 128, HTB = HALF * BK * 2, NXCD = 8, WGM = 8;
DEVI int lds_byte(int r, int c) { const int st = (r >> 4) * 2 + (c >> 5), rr = r & 15, cc = c & 31, ob = rr * 64 + cc * 2; return st * 1024 + (ob ^ (((ob >> 9) & 1) << 5)); }
DEVI void stage_rc(int b, int& R, int& C) { const int st = b / 1024, sb = b % 1024, swz = sb ^ (((sb >> 9) & 1) << 5); R = (st >> 1) * 16 + swz / 64; C = (st & 1) * 32 + (swz % 64) / 2; }
DEVI int perm32(int rho) { const int n = rho >> 4, i = rho & 15; return 8 * (i >> 2) + 4 * n + (i & 3); }
struct Unit { int pm, pn; };
struct Gemm { const bf16_t* A; const bf16_t* Bt; int M, N, K; };
struct StaticOrder {
    int nM, nN, nwg, G, c;
    DEVI void init(int M, int N, int G_, int c_) { nM = M / BM; nN = N / BM; nwg = nM * nN; G = G_; c = c_; }
    DEVI bool next(int i, Unit& u) const {
        const long L = (long)i * G + c; if (L >= nwg) return false;
        int wgid = (int)L; { const int q = nwg / NXCD, r = nwg % NXCD, xcd = wgid % NXCD, off = wgid / NXCD; wgid = (xcd < r ? xcd * (q + 1) : r * (q + 1) + (xcd - r) * q) + off; }
        const int nig = WGM * nN, gid = wgid / nig, fm = gid * WGM, gsz = (nM - fm) < WGM ? (nM - fm) : WGM;
        u.pm = fm + ((wgid % nig) % gsz); u.pn = (wgid % nig) / gsz; return true;
    }
};
template <class Epi>
DEVI void gemm_phase(LAS unsigned char* lds, const Gemm g, const StaticOrder& S, const Epi& E) {
    const int tid = opaque_tid(), wid = __builtin_amdgcn_readfirstlane(tid >> 6), lane = tid & 63, wr = wid >> 2, wc = wid & 3, fr = lane & 15, fq = lane >> 4;
    const int K = g.K, nt = K / BK;
    unsigned voffA[2], voffB[2];
#pragma unroll
    for (int i = 0; i < 2; ++i) { int R, C; stage_rc(tid * 16 + i * 8192, R, C); const int Rb = (R & ~31) + perm32(R & 31);
        voffA[i] = (unsigned)(R * K + C) * 2u; voffB[i] = (unsigned)(Rb * K + C) * 2u; }
    const size_t kstep = (size_t)(BK * 2);
    const size_t hstep = (size_t)HALF * K * 2;
    const size_t tstep = 2 * hstep;
    const unsigned ldsw = (unsigned)wid * 1024u;
    const int aoff = lds_byte(wr * 64 + fr, fq * 8), boff = lds_byte(wc * 32 + fr, fq * 8);
#define PG8_SA(b, h) (((b) * 2 + (h)) * HTB)
#define PG8_SB(b, h) ((4 + (b) * 2 + (h)) * HTB)
#define PG8_STAGE(bufoff, gbase, voff) do { _Pragma("unroll") for (int _i = 0; _i < 2; ++_i) \
        __builtin_amdgcn_global_load_lds((const unsigned*)((const char*)(gbase) + (voff)[_i]), (LAS unsigned*)(lds + (bufoff) + ldsw + _i * 8192), 16, 0, 0); } while (0)
#define PG8_LDA(dst, b, h) do { _Pragma("unroll") for (int m = 0; m < 4; ++m) _Pragma("unroll") for (int k = 0; k < 2; ++k) dst[m][k] = *(const LAS bf16x8*)(lds + PG8_SA(b, h) + aoff + m * 2048 + k * 1024); } while (0)
#define PG8_LDB(dst, b, h) do { _Pragma("unroll") for (int n = 0; n < 2; ++n) _Pragma("unroll") for (int k = 0; k < 2; ++k) dst[n][k] = *(const LAS bf16x8*)(lds + PG8_SB(b, h) + boff + n * 2048 + k * 1024); } while (0)
#define PG8_MMA(ai, bj, At, Bt) do { __builtin_amdgcn_s_setprio(1); _Pragma("unroll") for (int m = 0; m < 4; ++m) _Pragma("unroll") for (int n = 0; n < 2; ++n) _Pragma("unroll") for (int k = 0; k < 2; ++k) \
        acc[ai][bj][m][n] = __builtin_amdgcn_mfma_f32_16x16x32_bf16(Bt[n][k], At[m][k], acc[ai][bj][m][n], 0, 0, 0); __builtin_amdgcn_s_setprio(0); } while (0)
#define PG8_WAIT_V(n) asm volatile("s_waitcnt vmcnt(" #n ")" ::: "memory")
#define PG8_WAIT_L(n) asm volatile("s_waitcnt lgkmcnt(" #n ")" ::: "memory")
#define PG8_BAR __builtin_amdgcn_s_barrier()
#define PG8_SCHED __builtin_amdgcn_sched_barrier(0)
    Unit cur, nxt; int ui = 0;
    if (!S.next(0, cur)) return;
    f32x4 acc[2][2][4][2];
#pragma unroll
    for (int a = 0; a < 2; ++a)
#pragma unroll
        for (int b = 0; b < 2; ++b)
#pragma unroll
            for (int m = 0; m < 4; ++m)
#pragma unroll
                for (int n = 0; n < 2; ++n) acc[a][b][m][n] = (f32x4){0.f, 0.f, 0.f, 0.f};
    bf16x8 At[4][2], B0[2][2], B1[2][2];
    const char* cA = (const char*)g.A + (size_t)cur.pm * tstep; const char* cB = (const char*)g.Bt + (size_t)cur.pn * tstep;
    PG8_STAGE(PG8_SB(0, 0), cB, voffB); PG8_STAGE(PG8_SA(0, 0), cA, voffA); PG8_STAGE(PG8_SB(0, 1), cB + hstep, voffB); PG8_STAGE(PG8_SA(0, 1), cA + hstep, voffA);
    if (wr == 1) PG8_BAR;
    PG8_WAIT_V(4); PG8_BAR;
    PG8_STAGE(PG8_SB(1, 0), cB + kstep, voffB); PG8_STAGE(PG8_SA(1, 0), cA + kstep, voffA); PG8_STAGE(PG8_SB(1, 1), cB + hstep + kstep, voffB);
    PG8_WAIT_V(6); PG8_BAR;
    for (;;) {
        const bool has_next = S.next(ui + 1, nxt);
        const char* nA = has_next ? (const char*)g.A + (size_t)nxt.pm * tstep : cA; const char* nB = has_next ? (const char*)g.Bt + (size_t)nxt.pn * tstep : cB;
        for (int t = 0; t < nt; t += 2) {
            const bool last = (t == nt - 2);
            const char* a1 = cA + (size_t)(t + 1) * kstep;
            const char* a2 = last ? nA : cA + (size_t)(t + 2) * kstep; const char* b2 = last ? nB : cB + (size_t)(t + 2) * kstep;
            const char* a3 = a2 + kstep; const char* b3 = b2 + kstep;
            PG8_LDB(B0, 0, 0); PG8_SCHED; PG8_LDA(At, 0, 0); PG8_STAGE(PG8_SA(1, 1), a1 + hstep, voffA);
            PG8_WAIT_L(8); PG8_BAR; PG8_WAIT_L(0); PG8_MMA(0, 0, At, B0); PG8_BAR; PG8_SCHED;
            PG8_LDB(B1, 0, 1); PG8_STAGE(PG8_SB(0, 0), b2, voffB);
            PG8_BAR; PG8_WAIT_L(0); PG8_MMA(0, 1, At, B1); PG8_BAR;
            PG8_LDA(At, 0, 1); PG8_STAGE(PG8_SA(0, 0), a2, voffA);
            PG8_BAR; PG8_WAIT_L(0); PG8_MMA(1, 0, At, B0); PG8_BAR; PG8_SCHED;
            PG8_STAGE(PG8_SB(0, 1), b2 + hstep, voffB);
            PG8_WAIT_V(6); PG8_BAR; PG8_MMA(1, 1, At, B1); PG8_BAR;
            PG8_LDB(B0, 1, 0); PG8_SCHED; PG8_LDA(At, 1, 0); PG8_STAGE(PG8_SA(0, 1), a2 + hstep, voffA);
            PG8_WAIT_L(8); PG8_BAR; PG8_WAIT_L(0); PG8_MMA(0, 0, At, B0); PG8_BAR; PG8_SCHED;
            PG8_LDB(B1, 1, 1); PG8_STAGE(PG8_SB(1, 0), b3, voffB);
            PG8_BAR; PG8_WAIT_L(0); PG8_MMA(0, 1, At, B1); PG8_BAR;
            PG8_LDA(At, 1, 1); PG8_STAGE(PG8_SA(1, 0), a3, voffA);
            PG8_BAR; PG8_WAIT_L(0); PG8_MMA(1, 0, At, B0); PG8_BAR; PG8_SCHED;
            PG8_STAGE(PG8_SB(1, 1), b3 + hstep, voffB);
            PG8_WAIT_V(6); PG8_BAR; PG8_MMA(1, 1, At, B1); PG8_BAR;
        }
        E(acc, cur, wr, wc, fr, fq);
        if (!has_next) break;
#pragma unroll
        for (int a = 0; a < 2; ++a)
#pragma unroll
            for (int b = 0; b < 2; ++b)
#pragma unroll
                for (int m = 0; m < 4; ++m)
#pragma unroll
                    for (int n = 0; n < 2; ++n) acc[a][b][m][n] = (f32x4){0.f, 0.f, 0.f, 0.f};
        cur = nxt; cA = nA; cB = nB; ++ui;
    }
    PG8_WAIT_V(0);
    if (wr == 0) PG8_BAR;
    PG8_BAR;
#undef PG8_SA
#undef PG8_SB
#undef PG8_STAGE
#undef PG8_LDA
#undef PG8_LDB
#undef PG8_MMA
#undef PG8_WAIT_V
#undef PG8_WAIT_L
#undef PG8_BAR
#undef PG8_SCHED
}

DEVI float row_rs(const float* rowss, int row) {
    const f32x4* rp = (const f32x4*)(rowss + (size_t)row * 16);
    const f32x4 a = (rp[0] + rp[1]) + (rp[2] + rp[3]);
    const float ss = (a[0] + a[1]) + (a[2] + a[3]);
    return rsqrtf(ss * (1.f / 1024.f) + EPS);
}
DEVI float row_rs4(const float* rowss, int row, int fq) {
    const f32x4 a = *(const f32x4*)(rowss + (size_t)row * 16 + fq * 4);
    float ss = (a[0] + a[1]) + (a[2] + a[3]);
    ss += __shfl_xor(ss, 16);
    ss += __shfl_xor(ss, 32);
    return rsqrtf(ss * (1.f / 1024.f) + EPS);
}
DEVI u32x4 pk8(f32x4 a, f32x4 b) { u32x4 r; r.x = pk_bf16(a[0], a[1]); r.y = pk_bf16(a[2], a[3]); r.z = pk_bf16(b[0], b[1]); r.w = pk_bf16(b[2], b[3]); return r; }

struct EpiIn {
    const float* rowss; const float* rope; bf16_t *Q, *Kb, *Vb, *U; float* out; int l;
    DEVI void operator()(const f32x4 (&acc)[2][2][4][2], const Unit& u, int wr, int wc, int fr, int fq) const {
#pragma unroll
        for (int ai = 0; ai < 2; ++ai)
#pragma unroll
            for (int m = 0; m < 4; ++m) {
                const int row = u.pm * 256 + ai * 128 + wr * 64 + m * 16 + fr;
                const float rs = row_rs4(rowss, row, fq);
                const bool samp = row >= MP;
                int b, t;
                if (!samp) { b = row / LP; t = row - b * LP; } else { const int r = row - MP; b = r >> 3; t = r & 7; }
                const int pidx = samp ? LP + t : t;
#pragma unroll
                for (int bj = 0; bj < 2; ++bj) {
                    const int cb = u.pn * 256 + bj * 128 + wc * 32;
                    f32x4 v0 = acc[ai][bj][m][0] * rs, v1 = acc[ai][bj][m][1] * rs;
                    if (cb < 640 && (wc & 1) == 0) {
                        const f32x4 c0 = *(const f32x4*)(rope + pidx * 16), c1 = *(const f32x4*)(rope + pidx * 16 + 4);
                        const f32x4 s0 = *(const f32x4*)(rope + pidx * 16 + 8), s1 = *(const f32x4*)(rope + pidx * 16 + 12);
                        f32x4 p0, p1;
#pragma unroll
                        for (int jj = 0; jj < 4; ++jj) { p0[jj] = __shfl_xor(v0[jj], 16); p1[jj] = __shfl_xor(v1[jj], 16); }
                        if (fq < 2) {
                            const float sg = fq == 0 ? -1.f : 1.f;
                            v0 = v0 * c0 + p0 * s0 * sg; v1 = v1 * c1 + p1 * s1 * sg;
                        }
                    }
                    if (cb < 512) {
                        *(u32x4*)(Q + (size_t)row * 512 + cb + 8 * fq) = pk8(v0 * 0.125f, v1 * 0.125f);
                    } else if (cb < 768) {
                        const bool isk = cb < 640;
                        const int kc = (isk ? cb - 512 : cb - 640) + 8 * fq;
                        *(u32x4*)((isk ? Kb : Vb) + (size_t)row * 128 + kc) = pk8(v0, v1);
                        float* dst = nullptr;
                        if (!samp) { if (t >= LP - 128) dst = out + (isk ? O_NKP : O_NVP) + ((size_t)((l * 16 + b) * 128 + (t - (LP - 128)))) * 128; }
                        else dst = out + (isk ? O_NKS : O_NVS) + ((size_t)((l * 128 + b) * 128 + 120 + t)) * 128;
                        if (dst) { *(f32x4*)(dst + kc) = v0; *(f32x4*)(dst + kc + 4) = v1; }
                    } else {
                        const int uc = cb - 768 + 8 * fq;
                        *(u32x4*)(U + (size_t)row * 512 + uc) = pk8(v0, v1);
                        float* dst = nullptr;
                        if (!samp) { if (t >= LP - 15) dst = out + O_NPP + ((size_t)((l * 16 + b) * 15 + (t - (LP - 15)))) * 512; }
                        else dst = out + O_NPS + ((size_t)((l * 128 + b) * 15 + 7 + t)) * 512;
                        if (dst) { *(f32x4*)(dst + uc) = v0; *(f32x4*)(dst + uc + 4) = v1; }
                    }
                }
            }
    }
};

DEVI void unpk8(const u32x4 w, f32x4& a, f32x4& b) {
    a[0] = bf_lo(w.x); a[1] = bf_hi(w.x); a[2] = bf_lo(w.y); a[3] = bf_hi(w.y);
    b[0] = bf_lo(w.z); b[1] = bf_hi(w.z); b[2] = bf_lo(w.w); b[3] = bf_hi(w.w);
}
struct EpiRes {
    bf16_t* Hb; float* rowss;
    DEVI void operator()(const f32x4 (&acc)[2][2][4][2], const Unit& u, int wr, int wc, int fr, int fq) const {
#pragma unroll
        for (int ai = 0; ai < 2; ++ai) {
#pragma unroll
            for (int m = 0; m < 4; ++m) {
                const int row = u.pm * 256 + ai * 128 + wr * 64 + m * 16 + fr;
                float ss = 0.f;
#pragma unroll
                for (int bj = 0; bj < 2; ++bj) {
                    const size_t o = (size_t)row * DM + u.pn * 256 + bj * 128 + wc * 32 + 8 * fq;
                    f32x4 h0, h1;
                    unpk8(*(const u32x4*)(Hb + o), h0, h1);
                    h0 = h0 + acc[ai][bj][m][0]; h1 = h1 + acc[ai][bj][m][1];
                    *(u32x4*)(Hb + o) = pk8(h0, h1);
                    ss += ((h0[0] * h0[0] + h0[1] * h0[1]) + (h0[2] * h0[2] + h0[3] * h0[3])) + ((h1[0] * h1[0] + h1[1] * h1[1]) + (h1[2] * h1[2] + h1[3] * h1[3]));
                }
                ss += __shfl_xor(ss, 16);
                ss += __shfl_xor(ss, 32);
                if (fq == 0) rowss[(size_t)row * 16 + u.pn * 4 + wc] = ss;
            }
            __builtin_amdgcn_sched_barrier(0);
        }
    }
};

struct EpiUp {
    const float* rowss; bf16_t* ACT;
    DEVI void operator()(const f32x4 (&acc)[2][2][4][2], const Unit& u, int wr, int wc, int fr, int fq) const {
#pragma unroll
        for (int ai = 0; ai < 2; ++ai)
#pragma unroll
            for (int m = 0; m < 4; ++m) {
                const int row = u.pm * 256 + ai * 128 + wr * 64 + m * 16 + fr;
                const float rs = row_rs4(rowss, row, fq);
#pragma unroll
                for (int bj = 0; bj < 2; ++bj) {
                    f32x4 a0 = acc[ai][bj][m][0] * rs, a1 = acc[ai][bj][m][1] * rs;
#pragma unroll
                    for (int e = 0; e < 4; ++e) { const float x = fmaxf(a0[e], 0.f); a0[e] = x * x; const float y = fmaxf(a1[e], 0.f); a1[e] = y * y; }
                    *(u32x4*)(ACT + (size_t)row * DFF + u.pn * 256 + bj * 128 + wc * 32 + 8 * fq) = pk8(a0, a1);
                }
            }
    }
};

DEVI void transpose_tile(const float* __restrict__ W, int N, const float* __restrict__ g, bf16_t* __restrict__ Wt, int ldk, int kt, int nt_, LAS float* t, int ltid) {
    __syncthreads();
    {
        const int ty = ltid >> 4, n4 = (ltid & 15) * 4;
#pragma unroll
        for (int i = 0; i < 4; ++i) {
            const int k = ty + 16 * i;
            f32x4 v = *(const f32x4*)(W + (size_t)(kt * 64 + k) * N + nt_ * 64 + n4);
            const float s = g ? g[kt * 64 + k] : 1.f;
            t[k * 65 + n4 + 0] = v[0] * s; t[k * 65 + n4 + 1] = v[1] * s; t[k * 65 + n4 + 2] = v[2] * s; t[k * 65 + n4 + 3] = v[3] * s;
        }
    }
    __syncthreads();
    {
        const int n = ltid >> 2, kq = (ltid & 3) * 16;
        u32x4 o0, o1;
        o0.x = pk_bf16(t[(kq + 0) * 65 + n], t[(kq + 1) * 65 + n]);   o0.y = pk_bf16(t[(kq + 2) * 65 + n], t[(kq + 3) * 65 + n]);
        o0.z = pk_bf16(t[(kq + 4) * 65 + n], t[(kq + 5) * 65 + n]);   o0.w = pk_bf16(t[(kq + 6) * 65 + n], t[(kq + 7) * 65 + n]);
        o1.x = pk_bf16(t[(kq + 8) * 65 + n], t[(kq + 9) * 65 + n]);   o1.y = pk_bf16(t[(kq + 10) * 65 + n], t[(kq + 11) * 65 + n]);
        o1.z = pk_bf16(t[(kq + 12) * 65 + n], t[(kq + 13) * 65 + n]); o1.w = pk_bf16(t[(kq + 14) * 65 + n], t[(kq + 15) * 65 + n]);
        bf16_t* d = Wt + (size_t)(nt_ * 64 + n) * ldk + kt * 64 + kq;
        *(u32x4*)d = o0; *(u32x4*)(d + 8) = o1;
    }
}

DEVI bf16_t* wt_in(unsigned char* ws, int l) { return (bf16_t*)(ws + OFF_W) + (size_t)l * WL_E; }
DEVI bf16_t* wt_out(unsigned char* ws, int l) { return wt_in(ws, l) + WIN_E; }
DEVI bf16_t* wt_up(unsigned char* ws, int l) { return wt_out(ws, l) + WOUT_E; }
DEVI bf16_t* wt_dn(unsigned char* ws, int l) { return wt_up(ws, l) + WUP_E; }

constexpr int U_TRL = (320 + 128 + 1024 + 1024) / 2;
constexpr int U_TR = 2 * U_TRL;
constexpr int U_WC = U_TR + 64;
constexpr int U_ROWS = U_WC + MT / 8;
constexpr int U_ROPE = U_ROWS + (NROPE * 8 + NTHR - 1) / NTHR;
constexpr int U_CK = U_ROPE + 256;
constexpr int U_CV = U_CK + 256;
constexpr int U_CP = U_CV + 256;

DEVI void prologue(const Params& p, LAS unsigned char* lds) {
    const int tid = opaque_tid(), lane = tid & 63, wid = tid >> 6, sb = tid >> 8, ltid = tid & 255;
    bf16_t* Hb = (bf16_t*)(p.ws + OFF_HB);
    float* rowss = (float*)(p.ws + OFF_RS);
    float* rope = (float*)(p.ws + OFF_ROPE);
    LAS float* tl = (LAS float*)(lds + sb * 16640);
    for (int u = blockIdx.x; u < U_CP; u += gridDim.x) {
        if (u < U_TR) {
            const int l = u / U_TRL; int r = (u - l * U_TRL) * 2 + sb;
            if (r < 320) { transpose_tile(p.w_in + (size_t)l * DM * INW, INW, p.ln1 + l * DM, wt_in(p.ws, l), DM, r & 15, r >> 4, tl, ltid); }
            else if ((r -= 320) < 128) { transpose_tile(p.w_out + (size_t)l * DM * DM, DM, nullptr, wt_out(p.ws, l), DM, r & 7, r >> 3, tl, ltid); }
            else if ((r -= 128) < 1024) { transpose_tile(p.w_up + (size_t)l * DM * DFF, DFF, p.ln2 + l * DM, wt_up(p.ws, l), DM, r & 15, r >> 4, tl, ltid); }
            else { r -= 1024; transpose_tile(p.w_down + (size_t)l * DFF * DM, DM, nullptr, wt_dn(p.ws, l), DFF, r & 63, r >> 6, tl, ltid); }
        } else if (u < U_WC) {
            const int r = u - U_TR, l = r >> 5, g = (r >> 3) & 3, n = (r & 7) * 128 + (wid >> 2) * 64 + lane, c0 = (wid & 3) * 32;
            const float* pw = p.pool_w + ((size_t)(l * 4 + g) * 128 + c0) * 128;
            const float* sc = p.pool_scale + l * 512 + g * 128;
            const float* wo = p.w_out + (size_t)l * DM * DM + (size_t)(512 + g * 128) * DM + n;
            float acc[32];
#pragma unroll
            for (int c = 0; c < 32; ++c) acc[c] = 0.f;
            for (int e = 0; e < 128; ++e) {
                const float w = wo[(size_t)e * DM] * sc[e];
#pragma unroll
                for (int c = 0; c < 32; ++c) acc[c] += pw[c * 128 + e] * w;
            }
            bf16_t* d = wt_out(p.ws, l) + (size_t)n * DM + 512 + g * 128 + c0;
#pragma unroll
            for (int c = 0; c < 32; c += 8) {
                u32x4 o; o.x = pk_bf16(acc[c], acc[c + 1]); o.y = pk_bf16(acc[c + 2], acc[c + 3]); o.z = pk_bf16(acc[c + 4], acc[c + 5]); o.w = pk_bf16(acc[c + 6], acc[c + 7]);
                *(u32x4*)(d + c) = o;
            }
        } else if (u < U_ROWS) {
            const int row = (u - U_WC) * 8 + wid;
            const float* src;
            if (row < MP) { const int b = row / LP, t = row - b * LP; src = t < 16 ? p.meta + (size_t)t * DM : p.x_prompt + ((size_t)b * 2048 + (t - 16)) * DM; }
            else src = p.x_sample + (size_t)(row - MP) * DM;
            float ss = 0.f;
#pragma unroll
            for (int i = 0; i < 4; ++i) {
                const int c = i * 256 + lane * 4;
                const f32x4 v = *(const f32x4*)(src + c);
                *(u32x2*)(Hb + (size_t)row * DM + c) = pk4(v);
                ss += (v[0] * v[0] + v[1] * v[1]) + (v[2] * v[2] + v[3] * v[3]);
            }
#pragma unroll
            for (int o = 32; o >= 1; o >>= 1) ss += __shfl_xor(ss, o);
            if (lane < 16) rowss[(size_t)row * 16 + lane] = lane == 0 ? ss : 0.f;
        } else if (u < U_ROPE) {
            const int id = (u - U_ROWS) * NTHR + tid;
            if (id < NROPE * 8) {
                const int idx = id >> 3, i = id & 7;
                const int pos = idx < LP ? idx : 16384 + (idx - LP);
                const float inv = exp2f(-(float)i * 0.125f * 18.931568569324174f);
                const float ang = (float)pos * inv;
                double rev = (double)ang * 0.15915494309189535;
                rev -= rint(rev);
                const float red = (float)(rev * 6.283185307179586);
                rope[idx * 16 + i] = __cosf(red);
                rope[idx * 16 + 8 + i] = __sinf(red);
            }
        } else if (u < U_CV) {
            const bool isk = u < U_CK;
            const int r = isk ? u - U_ROPE : u - U_CK;
            const f32x4* src = (const f32x4*)((isk ? p.cache_k : p.cache_v) + (size_t)r * 128 * 128 + 8 * 128);
            f32x4* dst = (f32x4*)(p.out + (isk ? O_NKS : O_NVS) + (size_t)r * 128 * 128);
            for (int i = tid; i < 120 * 32; i += NTHR) dst[i] = src[i];
        } else {
            const int r = u - U_CV;
            const f32x4* src = (const f32x4*)(p.state_pool + (size_t)r * 15 * 512 + 8 * 512);
            f32x4* dst = (f32x4*)(p.out + O_NPS + (size_t)r * 15 * 512);
            for (int i = tid; i < 7 * 128; i += NTHR) dst[i] = src[i];
        }
    }
    __syncthreads();
}

constexpr int N_PU = NBATCH * 65;
constexpr int N_AU = N_PU + DB;

DEVI void add8(f32x4& a0, f32x4& a1, const u32x4 w) {
    a0[0] += bf_lo(w.x); a0[1] += bf_hi(w.x); a0[2] += bf_lo(w.y); a0[3] += bf_hi(w.y);
    a1[0] += bf_lo(w.z); a1[1] += bf_hi(w.z); a1[2] += bf_lo(w.w); a1[3] += bf_hi(w.w);
}

DEVI void mixer_phase(const Params& p, const int l, LAS unsigned char* lds_all) {
    const int tid0 = opaque_tid(), tid = tid0 & 255, kvh = tid0 >> 8, lane = tid & 63, wid = tid >> 6, fr = lane & 15, fq = lane >> 4;
    const bf16_t* Q = (const bf16_t*)(p.ws + OFF_OV + OV_Q);
    const bf16_t* Kb = (const bf16_t*)(p.ws + OFF_OV + OV_K);
    const bf16_t* Vb = (const bf16_t*)(p.ws + OFF_OV + OV_V);
    const bf16_t* U = (const bf16_t*)(p.ws + OFF_OV + OV_U);
    bf16_t* MIX = (bf16_t*)(p.ws + OFF_OV + OV_MIX);
    LAS unsigned char* Ks = lds_all + kvh * 44544;
    LAS bf16_t* Vt = (LAS bf16_t*)(Ks + 160 * 144);
    for (int unit = blockIdx.x; unit < N_AU; unit += gridDim.x) {
        const bool samp = unit >= N_PU;
        int b, t0;
        if (!samp) { b = unit / 65; t0 = (unit - b * 65) * 32; }
        else { b = unit - N_PU; t0 = 0; }
        const int rowbase = samp ? MP + b * 8 : b * LP;

        if (!samp) {
#pragma unroll 1
            for (int i = 0; i < 4; ++i) {
                const int c = tid + 256 * i, ir = c >> 5, ch = kvh * 256 + (c & 31) * 8, g = ch >> 7, w = 2 << g, pos = t0 + ir;
                if (pos < LP) {
                    const int n = (pos + 1) < w ? (pos + 1) : w;
                    const bf16_t* up = U + (size_t)(rowbase + pos) * 512 + ch;
                    f32x4 a0 = {0.f, 0.f, 0.f, 0.f}, a1 = {0.f, 0.f, 0.f, 0.f}, u0 = a0, u1 = a0;
                    add8(u0, u1, *(const u32x4*)up);
                    for (int ii = 1; ii < n; ++ii) add8(a0, a1, *(const u32x4*)(up - (size_t)ii * 512));
                    const float inv = 1.f / (float)n;
                    a0 = (a0 + u0) * inv - u0; a1 = (a1 + u1) * inv - u1;
                    *(u32x4*)(MIX + (size_t)(rowbase + pos) * 1024 + 512 + ch) = pk8(a0, a1);
                }
            }
        } else {
            const int s = tid >> 5, ch = kvh * 256 + (tid & 31) * 8, g = ch >> 7, w = 2 << g;
            f32x4 a0 = {0.f, 0.f, 0.f, 0.f}, a1 = {0.f, 0.f, 0.f, 0.f}, u0 = a0, u1 = a0;
            add8(u0, u1, *(const u32x4*)(U + (size_t)(rowbase + s) * 512 + ch));
            for (int ii = 1; ii < w; ++ii) {
                const int r = s - ii;
                if (r >= 0) add8(a0, a1, *(const u32x4*)(U + (size_t)(rowbase + r) * 512 + ch));
                else { const float* sp = p.state_pool + ((size_t)(l * 128 + b) * 15 + (15 + r)) * 512 + ch; a0 = a0 + *(const f32x4*)sp; a1 = a1 + *(const f32x4*)(sp + 4); }
            }
            const float inv = 1.f / (float)w;
            a0 = (a0 + u0) * inv - u0; a1 = (a1 + u1) * inv - u1;
            *(u32x4*)(MIX + (size_t)(rowbase + s) * 1024 + 512 + ch) = pk8(a0, a1);
        }

        u32x4 kq[5], vq[5];
#pragma unroll
        for (int i = 0; i < 5; ++i) {
            const int c = tid + 256 * i, j = c >> 3, dc = c & 7;
            kq[i] = (u32x4){0u, 0u, 0u, 0u}; vq[i] = kq[i];
            if (!samp) {
                const int kpos = t0 - 128 + j;
                if (kpos >= 0 && kpos < LP) {
                    const size_t o = (size_t)(rowbase + kpos) * 128 + kvh * 64 + dc * 8;
                    kq[i] = *(const u32x4*)(Kb + o); vq[i] = *(const u32x4*)(Vb + o);
                }
            } else if (j < 128) {
                const size_t o = (((size_t)(l * 128 + b) * 128 + j) * 2 + kvh) * 64 + dc * 8;
                const f32x4 k0 = *(const f32x4*)(p.cache_k + o), k1 = *(const f32x4*)(p.cache_k + o + 4);
                const f32x4 v0 = *(const f32x4*)(p.cache_v + o), v1 = *(const f32x4*)(p.cache_v + o + 4);
                kq[i] = pk8(k0, k1); vq[i] = pk8(v0, v1);
            } else if (j < 136) {
                const size_t o = (size_t)(rowbase + j - 128) * 128 + kvh * 64 + dc * 8;
                kq[i] = *(const u32x4*)(Kb + o); vq[i] = *(const u32x4*)(Vb + o);
            }
        }
        const int h = kvh * 4 + wid;
        bf16x8 qf[2][2];
#pragma unroll
        for (int qt = 0; qt < 2; ++qt) {
            const int i = qt * 16 + fr;
            const bool ok = samp ? (i < 8) : (t0 + i < LP);
            const bf16_t* qp = Q + (size_t)(rowbase + (samp ? 0 : t0) + i) * 512 + h * 64 + fq * 8;
#pragma unroll
            for (int ks = 0; ks < 2; ++ks) {
                u32x4 w = {0u, 0u, 0u, 0u};
                if (ok) w = *(const u32x4*)(qp + ks * 32);
                qf[qt][ks] = __builtin_bit_cast(bf16x8, w);
            }
        }
        __syncthreads();
#pragma unroll
        for (int i = 0; i < 5; ++i) {
            const int c = tid + 256 * i, j = c >> 3, dc = c & 7;
            *(LAS u32x4*)(Ks + j * 144 + dc * 16) = kq[i];
            LAS bf16_t* vt = Vt + (dc * 8) * 168 + j;
            vt[0 * 168] = (bf16_t)(vq[i].x & 0xffff); vt[1 * 168] = (bf16_t)(vq[i].x >> 16);
            vt[2 * 168] = (bf16_t)(vq[i].y & 0xffff); vt[3 * 168] = (bf16_t)(vq[i].y >> 16);
            vt[4 * 168] = (bf16_t)(vq[i].z & 0xffff); vt[5 * 168] = (bf16_t)(vq[i].z >> 16);
            vt[6 * 168] = (bf16_t)(vq[i].w & 0xffff); vt[7 * 168] = (bf16_t)(vq[i].w >> 16);
        }
        __syncthreads();

        f32x4 s[2][10];
#pragma unroll
        for (int t = 0; t < 10; ++t) {
            const bf16x8 k0 = *(const LAS bf16x8*)(Ks + (16 * t + fr) * 144 + fq * 16);
            const bf16x8 k1 = *(const LAS bf16x8*)(Ks + (16 * t + fr) * 144 + 64 + fq * 16);
#pragma unroll
            for (int qt = 0; qt < 2; ++qt) {
                f32x4 z = {0.f, 0.f, 0.f, 0.f};
                z = __builtin_amdgcn_mfma_f32_16x16x32_bf16(k0, qf[qt][0], z, 0, 0, 0);
                s[qt][t] = __builtin_amdgcn_mfma_f32_16x16x32_bf16(k1, qf[qt][1], z, 0, 0, 0);
            }
        }
        const float sink = p.sinks[l * 8 + h];
        float inv[2];
#pragma unroll
        for (int qt = 0; qt < 2; ++qt) {
            const int i = qt * 16 + fr;
            float mx = -INFINITY;
#pragma unroll
            for (int t = 0; t < 10; ++t)
#pragma unroll
                for (int jj = 0; jj < 4; ++jj) {
                    const int j = 16 * t + 4 * fq + jj;
                    const bool ok = (j >= i) && (j <= i + 128) && (samp || (t0 - 128 + j >= 0));
                    const float x = ok ? s[qt][t][jj] : -INFINITY;
                    s[qt][t][jj] = x;
                    mx = fmaxf(mx, x);
                }
            mx = fmaxf(mx, __shfl_xor(mx, 16));
            mx = fmaxf(mx, __shfl_xor(mx, 32));
            const float m = fmaxf(mx, sink);
            float sum = 0.f;
#pragma unroll
            for (int t = 0; t < 10; ++t)
#pragma unroll
                for (int jj = 0; jj < 4; ++jj) { const float e = __expf(s[qt][t][jj] - m); s[qt][t][jj] = e; sum += e; }
            sum += __shfl_xor(sum, 16);
            sum += __shfl_xor(sum, 32);
            inv[qt] = 1.f / (sum + __expf(sink - m));
        }
        f32x4 o[2][4];
#pragma unroll
        for (int qt = 0; qt < 2; ++qt)
#pragma unroll
            for (int dt = 0; dt < 4; ++dt) o[qt][dt] = (f32x4){0.f, 0.f, 0.f, 0.f};
#pragma unroll
        for (int pp = 0; pp < 5; ++pp) {
            bf16x8 pf[2];
#pragma unroll
            for (int qt = 0; qt < 2; ++qt) pf[qt] = __builtin_bit_cast(bf16x8, pk8(s[qt][2 * pp], s[qt][2 * pp + 1]));
#pragma unroll
            for (int dt = 0; dt < 4; ++dt) {
                const LAS bf16_t* vp = Vt + (16 * dt + fr) * 168 + 32 * pp + 4 * fq;
                const u32x2 v0 = *(const LAS u32x2*)vp, v1 = *(const LAS u32x2*)(vp + 16);
                const u32x4 vw = {v0.x, v0.y, v1.x, v1.y};
                const bf16x8 vf = __builtin_bit_cast(bf16x8, vw);
#pragma unroll
                for (int qt = 0; qt < 2; ++qt) o[qt][dt] = __builtin_amdgcn_mfma_f32_16x16x32_bf16(vf, pf[qt], o[qt][dt], 0, 0, 0);
            }
        }
#pragma unroll
        for (int qt = 0; qt < 2; ++qt) {
            const int i = qt * 16 + fr;
            const bool ok = samp ? (i < 8) : (t0 + i < LP);
            if (ok) {
                bf16_t* op = MIX + (size_t)(rowbase + (samp ? 0 : t0) + i) * 1024 + h * 64 + 4 * fq;
#pragma unroll
                for (int dt = 0; dt < 4; ++dt) *(u32x2*)(op + 16 * dt) = pk4(o[qt][dt] * inv[qt]);
            }
        }
    }
    __syncthreads();
}

DEVI void final_phase(const Params& p) {
    const int tid = opaque_tid(), lane = tid & 63, wid = tid >> 6;
    const bf16_t* Hb = (const bf16_t*)(p.ws + OFF_HB);
    const float* rowss = (const float*)(p.ws + OFF_RS);
    for (int u = blockIdx.x; u < MT / 8; u += gridDim.x) {
        const int row = u * 8 + wid;
        float* dst;
        if (row < MP) { const int b = row / LP, t = row - b * LP; if (t < 16) continue; dst = p.out + O_YP + ((size_t)b * 2048 + (t - 16)) * DM; }
        else dst = p.out + O_YS + (size_t)(row - MP) * DM;
        const float rs = row_rs(rowss, row);
#pragma unroll
        for (int i = 0; i < 2; ++i) {
            const int c = i * 512 + lane * 8;
            f32x4 v0, v1;
            unpk8(*(const u32x4*)(Hb + (size_t)row * DM + c), v0, v1);
            const f32x4 g0 = *(const f32x4*)(p.ln_f + c), g1 = *(const f32x4*)(p.ln_f + c + 4);
            *(f32x4*)(dst + c) = v0 * rs * g0; *(f32x4*)(dst + c + 4) = v1 * rs * g1;
        }
    }
}

#define XB_TMO      128
#define XB_XCNT(j)  (256  + 64 * (j))
#define XB_XSUB(j)  (1280 + 64 * (j))
#define XB_XGEN(j)  (2304 + 64 * (j))
#define XB_TOP      3328
#define XB_TOPGEN   3392
#define XCD_BAR_WORDS 3456
#define XB_SPIN_CAP (1u << 18)
DEVI unsigned xb_ld(unsigned* p)              { return __hip_atomic_load(p, __ATOMIC_RELAXED, __HIP_MEMORY_SCOPE_AGENT); }
DEVI unsigned xb_add(unsigned* p, unsigned v) { return __hip_atomic_fetch_add(p, v, __ATOMIC_RELAXED, __HIP_MEMORY_SCOPE_AGENT); }
DEVI unsigned xb_xcc_id() { return (unsigned)__builtin_amdgcn_s_getreg((3 << 11) | 20) & 0xFu; }
#define XB_SPIN(cond, bar) do { unsigned _sp = 0; while (cond) { __builtin_amdgcn_s_sleep(1); \
    if ((++_sp & 255u) == 0u) { if (xb_ld(&(bar)[XB_TMO])) break; if (_sp > XB_SPIN_CAP) { atomicAdd(&(bar)[XB_TMO], 1u); break; } } } } while (0)
struct XcdBarrier { unsigned* bar; unsigned x; volatile LAS unsigned* st; };
DEVI XcdBarrier xcd_barrier_post(unsigned* bar, volatile LAS unsigned* st) {
    XcdBarrier b; b.bar = bar; b.x = xb_xcc_id(); b.st = st;
    if (threadIdx.x == 0) (void)xb_add(&bar[XB_XCNT(b.x)], 1u);
    return b;
}
DEVI void xcd_barrier_complete(unsigned* bar, unsigned x, unsigned& nloc, unsigned& nx) {
    const unsigned G = gridDim.x * gridDim.y * gridDim.z;
    unsigned sum, cnt, mine, sp = 0u;
    for (;;) {
        sum = 0u; cnt = 0u; mine = 0u;
#pragma unroll
        for (unsigned j = 0; j < 16; ++j) { const unsigned c = xb_ld(&bar[XB_XCNT(j)]); sum += c; cnt += (c > 0u) ? 1u : 0u; mine = (j == x) ? c : mine; }
        if (sum == G) break;
        __builtin_amdgcn_s_sleep(1);
        if ((++sp & 255u) == 0u) { if (xb_ld(&bar[XB_TMO])) break; if (sp > XB_SPIN_CAP) { atomicAdd(&bar[XB_TMO], 1u); break; } }
    }
    nloc = mine > 0u ? mine : 1u; nx = cnt > 0u ? cnt : 1u;
}
DEVI void xcd_barrier(const XcdBarrier& b) {
    asm volatile("s_waitcnt vmcnt(0)" ::: "memory");
    __syncthreads();
    if (threadIdx.x == 0) {
        unsigned* bar = b.bar;
        __builtin_amdgcn_s_waitcnt(0);
        unsigned nloc = b.st[0], nx = b.st[1];
        if (nloc == 0u) { xcd_barrier_complete(bar, b.x, nloc, nx); b.st[0] = nloc; b.st[1] = nx; }
        const unsigned old = xb_add(&bar[XB_XSUB(b.x)], 1u);
        const unsigned gen = old / nloc;
        if (old + 1u == (gen + 1u) * nloc) {
            __builtin_amdgcn_fence(__ATOMIC_RELEASE, "agent");
            asm volatile("s_waitcnt vmcnt(0)" ::: "memory");
            const unsigned og = xb_add(&bar[XB_TOP], 1u);
            const unsigned tg = og / nx;
            if (og + 1u == (tg + 1u) * nx) xb_add(&bar[XB_TOPGEN], 1u);
            else XB_SPIN(xb_ld(&bar[XB_TOPGEN]) == tg, bar);
            __builtin_amdgcn_fence(__ATOMIC_ACQUIRE, "agent");
            xb_add(&bar[XB_XGEN(b.x)], 1u);
            asm volatile("s_waitcnt vmcnt(0)" ::: "memory");
        } else {
            XB_SPIN(xb_ld(&bar[XB_XGEN(b.x)]) == gen, bar);
            __builtin_amdgcn_fence(__ATOMIC_ACQUIRE, "agent");
            asm volatile("s_waitcnt vmcnt(0)" ::: "memory");
        }
    }
    __syncthreads();
}

__global__ void __launch_bounds__(NTHR, 2) hymba_fwd(Params p) {
    extern __shared__ __attribute__((aligned(16))) unsigned char lds_raw[];
    LAS unsigned char* lds = (LAS unsigned char*)lds_raw;
    cg::grid_group grid = cg::this_grid();
    bf16_t* Hb = (bf16_t*)(p.ws + OFF_HB);
    float* rowss = (float*)(p.ws + OFF_RS);
    const float* rope = (const float*)(p.ws + OFF_ROPE);
    bf16_t* Q = (bf16_t*)(p.ws + OFF_OV + OV_Q);
    bf16_t* Kb = (bf16_t*)(p.ws + OFF_OV + OV_K);
    bf16_t* Vb = (bf16_t*)(p.ws + OFF_OV + OV_V);
    bf16_t* U = (bf16_t*)(p.ws + OFF_OV + OV_U);
    bf16_t* MIX = (bf16_t*)(p.ws + OFF_OV + OV_MIX);
    bf16_t* ACT = (bf16_t*)(p.ws + OFF_OV);
    StaticOrder S;
    if (threadIdx.x < 4) ((LAS unsigned*)(lds + LDS_STAGE))[threadIdx.x] = 0u;
    __syncthreads();
    const XcdBarrier xb = xcd_barrier_post((unsigned*)(p.ws + OFF_BAR), (volatile LAS unsigned*)(lds + LDS_STAGE));

#ifndef SK_PRO
    prologue(p, lds);
#endif
#ifdef PROBE_PRO
    grid.sync();
    prologue(p, lds);
#endif
#ifdef PROBE_SYNC
    for (int i = 0; i < 10; ++i) grid.sync();
#endif
    grid.sync();
#pragma unroll 1
    for (int l = 0; l < 2; ++l) {
#ifndef SK_P1
        { EpiIn e{rowss, rope, Q, Kb, Vb, U, p.out, l}; S.init(MT, INW, gridDim.x, blockIdx.x); gemm_phase(lds, Gemm{Hb, wt_in(p.ws, l), MT, INW, DM}, S, e); }
#endif
        xcd_barrier(xb);
#ifndef SK_MIX
        mixer_phase(p, l, lds);
#endif
#ifdef PROBE_MIX
        xcd_barrier(xb);
        mixer_phase(p, l, lds);
#endif
        xcd_barrier(xb);
#ifndef SK_P3
        { EpiRes e{Hb, rowss}; S.init(MT, DM, gridDim.x, blockIdx.x); gemm_phase(lds, Gemm{MIX, wt_out(p.ws, l), MT, DM, DM}, S, e); }
#endif
        xcd_barrier(xb);
#ifndef SK_P4
        { EpiUp e{rowss, ACT}; S.init(MT, DFF, gridDim.x, blockIdx.x); gemm_phase(lds, Gemm{Hb, wt_up(p.ws, l), MT, DFF, DM}, S, e); }
#endif
        xcd_barrier(xb);
#ifndef SK_P5
        { EpiRes e{Hb, rowss}; S.init(MT, DM, gridDim.x, blockIdx.x); gemm_phase(lds, Gemm{ACT, wt_dn(p.ws, l), MT, DM, DFF}, S, e); }
#endif
        xcd_barrier(xb);
    }
    final_phase(p);
}

extern "C" void kernel_launch(void* const* d_in, const int* in_sizes, int n_in, void* d_out, int out_size, void* d_ws, size_t ws_size, hipStream_t stream) {
    if (ws_size < WS_NEED || (size_t)out_size != O_END || n_in != 16) {
        fprintf(stderr, "kernel_launch: unexpected sizes ws=%zu need=%zu out=%d need=%zu n_in=%d\n", ws_size, WS_NEED, out_size, O_END, n_in);
        return;
    }
    static int grid_blocks = 0;
    if (!grid_blocks) {
        int dev = 0, cus = 0, per_cu = 0;
        (void)hipGetDevice(&dev);
        (void)hipDeviceGetAttribute(&cus, hipDeviceAttributeMultiprocessorCount, dev);
        if (hipFuncSetAttribute((const void*)hymba_fwd, hipFuncAttributeMaxDynamicSharedMemorySize, LDS_BYTES) != hipSuccess) fprintf(stderr, "hipFuncSetAttribute failed\n");
        (void)hipOccupancyMaxActiveBlocksPerMultiprocessor(&per_cu, hymba_fwd, NTHR, LDS_BYTES);
        if (per_cu < 1) { fprintf(stderr, "occupancy query says %d\n", per_cu); per_cu = 1; }
        if (per_cu > 1) per_cu = 1;
        grid_blocks = cus * per_cu;
    }
    Params p{};
    p.x_prompt = (const float*)d_in[0]; p.x_sample = (const float*)d_in[1]; p.cache_k = (const float*)d_in[2]; p.cache_v = (const float*)d_in[3];
    p.state_pool = (const float*)d_in[4]; p.meta = (const float*)d_in[5]; p.ln1 = (const float*)d_in[6]; p.w_in = (const float*)d_in[7];
    p.sinks = (const float*)d_in[8]; p.pool_w = (const float*)d_in[9]; p.pool_scale = (const float*)d_in[10]; p.w_out = (const float*)d_in[11];
    p.ln2 = (const float*)d_in[12]; p.w_up = (const float*)d_in[13]; p.w_down = (const float*)d_in[14]; p.ln_f = (const float*)d_in[15];
    p.out = (float*)d_out; p.ws = (unsigned char*)d_ws;
    if (hipMemsetAsync((unsigned char*)d_ws + OFF_BAR, 0, BAR_BYTES, stream) != hipSuccess) fprintf(stderr, "memset failed\n");
    void* args[] = {&p};
    hipError_t e = hipLaunchCooperativeKernel((const void*)hymba_fwd, dim3(grid_blocks), dim3(NTHR), args, LDS_BYTES, stream);
    if (e != hipSuccess) fprintf(stderr, "cooperative launch failed: %s (grid %d)\n", hipGetErrorString(e), grid_blocks);
}
```

```cpp
#include <hip/hip_runtime.h>
#include <hip/hip_cooperative_groups.h>
#include <cstdio>
#include <cstdint>
namespace cg = cooperative_groups;

typedef unsigned short bf16_t;
typedef short bf16x8 __attribute__((ext_vector_type(8)));
typedef float f32x4 __attribute__((ext_vector_type(4)));
typedef unsigned u32x4 __attribute__((ext_vector_type(4)));
typedef unsigned u32x2 __attribute__((ext_vector_type(2)));
#define DEVI __device__ __forceinline__
#define LAS __attribute__((address_space(3)))

constexpr int DM = 1024, LP = 2064, NBATCH = 16, MP = NBATCH * LP  , DB = 128, DS = 8, MS = DB * DS  ;
constexpr int MT = MP + MS  , INW = 1280, DFF = 4096, NM = MT / 128  ;
constexpr int NROPE = LP + DS;
constexpr float EPS = 1e-5f;

constexpr size_t O_YP = 0;
constexpr size_t O_YS = O_YP + (size_t)16 * 2048 * 1024;
constexpr size_t O_NKP = O_YS + (size_t)128 * 8 * 1024;
constexpr size_t O_NVP = O_NKP + (size_t)2 * 16 * 128 * 128;
constexpr size_t O_NPP = O_NVP + (size_t)2 * 16 * 128 * 128;
constexpr size_t O_NKS = O_NPP + (size_t)2 * 16 * 15 * 512;
constexpr size_t O_NVS = O_NKS + (size_t)2 * 128 * 128 * 128;
constexpr size_t O_NPS = O_NVS + (size_t)2 * 128 * 128 * 128;
constexpr size_t O_END = O_NPS + (size_t)2 * 128 * 15 * 512;

constexpr size_t WIN_E = (size_t)INW * DM, WOUT_E = (size_t)DM * DM, WUP_E = (size_t)DFF * DM, WDN_E = (size_t)DM * DFF;
constexpr size_t WL_E = WIN_E + WOUT_E + WUP_E + WDN_E;
constexpr size_t OFF_W = 0;
constexpr size_t OFF_HB = OFF_W + 2 * WL_E * 2;
constexpr size_t OFF_RS = OFF_HB + (size_t)MT * DM * 2;
constexpr size_t OFF_ROPE = OFF_RS + (size_t)MT * 16 * 4;
constexpr size_t OFF_BAR = OFF_ROPE + (size_t)NROPE * 16 * 4;
constexpr size_t BAR_BYTES = 3456 * 4;
constexpr size_t OFF_OV = OFF_BAR + BAR_BYTES;
constexpr size_t OV_Q = 0;
constexpr size_t OV_K = OV_Q + (size_t)MT * 512 * 2;
constexpr size_t OV_V = OV_K + (size_t)MT * 128 * 2;
constexpr size_t OV_U = OV_V + (size_t)MT * 128 * 2;
constexpr size_t OV_MIX = OV_U + (size_t)MT * 512 * 2;
constexpr size_t OV_END = OV_MIX + (size_t)MT * 1024 * 2;
constexpr size_t WS_NEED = OFF_OV + (size_t)MT * DFF * 2;
static_assert(OV_END <= (size_t)MT * DFF * 2, "overlay");

constexpr int LDS_STAGE = 131072;
constexpr int LDS_BYTES = LDS_STAGE + 16;
constexpr int NTHR = 512;

struct Params {
    const float *x_prompt, *x_sample, *cache_k, *cache_v, *state_pool, *meta, *ln1, *w_in, *sinks, *pool_w, *pool_scale, *w_out, *ln2, *w_up, *w_down, *ln_f;
    float* out;
    unsigned char* ws;
};

DEVI unsigned pk_bf16(float lo, float hi) { unsigned r; asm("v_cvt_pk_bf16_f32 %0, %1, %2" : "=v"(r) : "v"(lo), "v"(hi)); return r; }
DEVI float bf_lo(unsigned w) { return __uint_as_float(w << 16); }
DEVI float bf_hi(unsigned w) { return __uint_as_float(w & 0xffff0000u); }
DEVI int opaque_tid() { int t = threadIdx.x; asm volatile("" : "+v"(t)); return t; }
DEVI u32x2 pk4(f32x4 v) { u32x2 r; r.x = pk_bf16(v[0], v[1]); r.y = pk_bf16(v[2], v[3]); return r; }

constexpr int BM = 256, BK = 64, HALF = 128, HTB = HALF * BK * 2, NXCD = 8, WGM = 8;
DEVI int lds_byte(int r, int c) { const int st = (r >> 4) * 2 + (c >> 5), rr = r & 15, cc = c & 31, ob = rr * 64 + cc * 2; return st * 1024 + (ob ^ (((ob >> 9) & 1) << 5)); }
DEVI void stage_rc(int b, int& R, int& C) { const int st = b / 1024, sb = b % 1024, swz = sb ^ (((sb >> 9) & 1) << 5); R = (st >> 1) * 16 + swz / 64; C = (st & 1) * 32 + (swz % 64) / 2; }
DEVI int perm32(int rho) { const int n = rho >> 4, i = rho & 15; return 8 * (i >> 2) + 4 * n + (i & 3); }
struct Unit { int pm, pn; };
struct Gemm { const bf16_t* A; const bf16_t* Bt; int M, N, K; };
struct StaticOrder {
    int nM, nN, nwg, G, c;
    DEVI void init(int M, int N, int G_, int c_) { nM = M / BM; nN = N / BM; nwg = nM * nN; G = G_; c = c_; }
    DEVI bool next(int i, Unit& u) const {
        const long L = (long)i * G + c; if (L >= nwg) return false;
        int wgid = (int)L; { const int q = nwg / NXCD, r = nwg % NXCD, xcd = wgid % NXCD, off = wgid / NXCD; wgid = (xcd < r ? xcd * (q + 1) : r * (q + 1) + (xcd - r) * q) + off; }
        const int nig = WGM * nN, gid = wgid / nig, fm = gid * WGM, gsz = (nM - fm) < WGM ? (nM - fm) : WGM;
        u.pm = fm + ((wgid % nig) % gsz); u.pn = (wgid % nig) / gsz; return true;
    }
};
template <class Epi>
DEVI void gemm_phase(LAS unsigned char* lds, const Gemm g, const StaticOrder& S, const Epi& E) {
    const int tid = opaque_tid(), wid = __builtin_amdgcn_readfirstlane(tid >> 6), lane = tid & 63, wr = wid >> 2, wc = wid & 3, fr = lane & 15, fq = lane >> 4;
    const int K = g.K, nt = K / BK;
    unsigned voffA[2], voffB[2];
#pragma unroll
    for (int i = 0; i < 2; ++i) { int R, C; stage_rc(tid * 16 + i * 8192, R, C); const int Rb = (R & ~31) + perm32(R & 31);
        voffA[i] = (unsigned)(R * K + C) * 2u; voffB[i] = (unsigned)(Rb * K + C) * 2u; }
    const size_t kstep = (size_t)(BK * 2);
    const size_t hstep = (size_t)HALF * K * 2;
    const size_t tstep = 2 * hstep;
    const unsigned ldsw = (unsigned)wid * 1024u;
    const int aoff = lds_byte(wr * 64 + fr, fq * 8), boff = lds_byte(wc * 32 + fr, fq * 8);
#define PG8_SA(b, h) (((b) * 2 + (h)) * HTB)
#define PG8_SB(b, h) ((4 + (b) * 2 + (h)) * HTB)
#define PG8_STAGE(bufoff, gbase, voff) do { _Pragma("unroll") for (int _i = 0; _i < 2; ++_i) \
        __builtin_amdgcn_global_load_lds((const unsigned*)((const char*)(gbase) + (voff)[_i]), (LAS unsigned*)(lds + (bufoff) + ldsw + _i * 8192), 16, 0, 0); } while (0)
#define PG8_LDA(dst, b, h) do { _Pragma("unroll") for (int m = 0; m < 4; ++m) _Pragma("unroll") for (int k = 0; k < 2; ++k) dst[m][k] = *(const LAS bf16x8*)(lds + PG8_SA(b, h) + aoff + m * 2048 + k * 1024); } while (0)
#define PG8_LDB(dst, b, h) do { _Pragma("unroll") for (int n = 0; n < 2; ++n) _Pragma("unroll") for (int k = 0; k < 2; ++k) dst[n][k] = *(const LAS bf16x8*)(lds + PG8_SB(b, h) + boff + n * 2048 + k * 1024); } while (0)
#define PG8_MMA(ai, bj, At, Bt) do { __builtin_amdgcn_s_setprio(1); _Pragma("unroll") for (int m = 0; m < 4; ++m) _Pragma("unroll") for (int n = 0; n < 2; ++n) _Pragma("unroll") for (int k = 0; k < 2; ++k) \
        acc[ai][bj][m][n] = __builtin_amdgcn_mfma_f32_16x16x32_bf16(Bt[n][k], At[m][k], acc[ai][bj][m][n], 0, 0, 0); __builtin_amdgcn_s_setprio(0); } while (0)
#define PG8_WAIT_V(n) asm volatile("s_waitcnt vmcnt(" #n ")" ::: "memory")
#define PG8_WAIT_L(n) asm volatile("s_waitcnt lgkmcnt(" #n ")" ::: "memory")
#define PG8_BAR __builtin_amdgcn_s_barrier()
#define PG8_SCHED __builtin_amdgcn_sched_barrier(0)
    Unit cur, nxt; int ui = 0;
    if (!S.next(0, cur)) return;
    f32x4 acc[2][2][4][2];
#pragma unroll
    for (int a = 0; a < 2; ++a)
#pragma unroll
        for (int b = 0; b < 2; ++b)
#pragma unroll
            for (int m = 0; m < 4; ++m)
#pragma unroll
                for (int n = 0; n < 2; ++n) acc[a][b][m][n] = (f32x4){0.f, 0.f, 0.f, 0.f};
    bf16x8 At[4][2], B0[2][2], B1[2][2];
    const char* cA = (const char*)g.A + (size_t)cur.pm * tstep; const char* cB = (const char*)g.Bt + (size_t)cur.pn * tstep;
    PG8_STAGE(PG8_SB(0, 0), cB, voffB); PG8_STAGE(PG8_SA(0, 0), cA, voffA); PG8_STAGE(PG8_SB(0, 1), cB + hstep, voffB); PG8_STAGE(PG8_SA(0, 1), cA + hstep, voffA);
    if (wr == 1) PG8_BAR;
    PG8_WAIT_V(4); PG8_BAR;
    PG8_STAGE(PG8_SB(1, 0), cB + kstep, voffB); PG8_STAGE(PG8_SA(1, 0), cA + kstep, voffA); PG8_STAGE(PG8_SB(1, 1), cB + hstep + kstep, voffB);
    PG8_WAIT_V(6); PG8_BAR;
    for (;;) {
        const bool has_next = S.next(ui + 1, nxt);
        const char* nA = has_next ? (const char*)g.A + (size_t)nxt.pm * tstep : cA; const char* nB = has_next ? (const char*)g.Bt + (size_t)nxt.pn * tstep : cB;
        for (int t = 0; t < nt; t += 2) {
            const bool last = (t == nt - 2);
            const char* a1 = cA + (size_t)(t + 1) * kstep;
            const char* a2 = last ? nA : cA + (size_t)(t + 2) * kstep; const char* b2 = last ? nB : cB + (size_t)(t + 2) * kstep;
            const char* a3 = a2 + kstep; const char* b3 = b2 + kstep;
            PG8_LDB(B0, 0, 0); PG8_SCHED; PG8_LDA(At, 0, 0); PG8_STAGE(PG8_SA(1, 1), a1 + hstep, voffA);
            PG8_WAIT_L(8); PG8_BAR; PG8_WAIT_L(0); PG8_MMA(0, 0, At, B0); PG8_BAR; PG8_SCHED;
            PG8_LDB(B1, 0, 1); PG8_STAGE(PG8_SB(0, 0), b2, voffB);
            PG8_BAR; PG8_WAIT_L(0); PG8_MMA(0, 1, At, B1); PG8_BAR;
            PG8_LDA(At, 0, 1); PG8_STAGE(PG8_SA(0, 0), a2, voffA);
            PG8_BAR; PG8_WAIT_L(0); PG8_MMA(1, 0, At, B0); PG8_BAR; PG8_SCHED;
            PG8_STAGE(PG8_SB(0, 1), b2 + hstep, voffB);
            PG8_WAIT_V(6); PG8_BAR; PG8_MMA(1, 1, At, B1); PG8_BAR;
            PG8_LDB(B0, 1, 0); PG8_SCHED; PG8_LDA(At, 1, 0); PG8_STAGE(PG8_SA(0, 1), a2 + hstep, voffA);
            PG8_WAIT_L(8); PG8_BAR; PG8_WAIT_L(0); PG8_MMA(0, 0, At, B0); PG8_BAR; PG8_SCHED;
            PG8_LDB(B1, 1, 1); PG8_STAGE(PG8_SB(1, 0), b3, voffB);
            PG8_BAR; PG8_WAIT_L(0); PG8_MMA(0, 1, At, B1); PG8_BAR;
            PG8_LDA(At, 1, 1); PG8_STAGE(PG8_SA(1, 0), a3, voffA);
            PG8_BAR; PG8_WAIT_L(0); PG8_MMA(1, 0, At, B0); PG8_BAR; PG8_SCHED;
            PG8_STAGE(PG8_SB(1, 1), b3 + hstep, voffB);
            PG8_WAIT_V(6); PG8_BAR; PG8_MMA(1, 1, At, B1); PG8_BAR;
        }
        E(acc, cur, wr, wc, fr, fq);
        if (!has_next) break;
#pragma unroll
        for (int a = 0; a < 2; ++a)
#pragma unroll
            for (int b = 0; b < 2; ++b)
#pragma unroll
                for (int m = 0; m < 4; ++m)
#pragma unroll
                    for (int n = 0; n < 2; ++n) acc[a][b][m][n] = (f32x4){0.f, 0.f, 0.f, 0.f};
        cur = nxt; cA = nA; cB = nB; ++ui;
    }
    PG8_WAIT_V(0);
    if (wr == 0) PG8_BAR;
    PG8_BAR;
#undef PG8_SA
#undef PG8_SB
#undef PG8_STAGE
#undef PG8_LDA
#undef PG8_LDB
#undef PG8_MMA
#undef PG8_WAIT_V
#undef PG8_WAIT_L
#undef PG8_BAR
#undef PG8_SCHED
}

DEVI float row_rs(const float* rowss, int row) {
    const f32x4* rp = (const f32x4*)(rowss + (size_t)row * 16);
    const f32x4 a = (rp[0] + rp[1]) + (rp[2] + rp[3]);
    const float ss = (a[0] + a[1]) + (a[2] + a[3]);
    return rsqrtf(ss * (1.f / 1024.f) + EPS);
}
DEVI float row_rs4(const float* rowss, int row, int fq) {
    const f32x4 a = *(const f32x4*)(rowss + (size_t)row * 16 + fq * 4);
    float ss = (a[0] + a[1]) + (a[2] + a[3]);
    ss += __shfl_xor(ss, 16);
    ss += __shfl_xor(ss, 32);
    return rsqrtf(ss * (1.f / 1024.f) + EPS);
}
DEVI u32x4 pk8(f32x4 a, f32x4 b) { u32x4 r; r.x = pk_bf16(a[0], a[1]); r.y = pk_bf16(a[2], a[3]); r.z = pk_bf16(b[0], b[1]); r.w = pk_bf16(b[2], b[3]); return r; }

struct EpiIn {
    const float* rowss; const float* rope; bf16_t *Q, *Kb, *Vb, *U; float* out; int l;
    DEVI void operator()(const f32x4 (&acc)[2][2][4][2], const Unit& u, int wr, int wc, int fr, int fq) const {
#pragma unroll
        for (int ai = 0; ai < 2; ++ai)
#pragma unroll
            for (int m = 0; m < 4; ++m) {
                const int row = u.pm * 256 + ai * 128 + wr * 64 + m * 16 + fr;
                const float rs = row_rs4(rowss, row, fq);
                const bool samp = row >= MP;
                int b, t;
                if (!samp) { b = row / LP; t = row - b * LP; } else { const int r = row - MP; b = r >> 3; t = r & 7; }
                const int pidx = samp ? LP + t : t;
#pragma unroll
                for (int bj = 0; bj < 2; ++bj) {
                    const int cb = u.pn * 256 + bj * 128 + wc * 32;
                    f32x4 v0 = acc[ai][bj][m][0] * rs, v1 = acc[ai][bj][m][1] * rs;
                    if (cb < 640 && (wc & 1) == 0) {
                        const f32x4 c0 = *(const f32x4*)(rope + pidx * 16), c1 = *(const f32x4*)(rope + pidx * 16 + 4);
                        const f32x4 s0 = *(const f32x4*)(rope + pidx * 16 + 8), s1 = *(const f32x4*)(rope + pidx * 16 + 12);
                        f32x4 p0, p1;
#pragma unroll
                        for (int jj = 0; jj < 4; ++jj) { p0[jj] = __shfl_xor(v0[jj], 16); p1[jj] = __shfl_xor(v1[jj], 16); }
                        if (fq < 2) {
                            const float sg = fq == 0 ? -1.f : 1.f;
                            v0 = v0 * c0 + p0 * s0 * sg; v1 = v1 * c1 + p1 * s1 * sg;
                        }
                    }
                    if (cb < 512) {
                        *(u32x4*)(Q + (size_t)row * 512 + cb + 8 * fq) = pk8(v0 * 0.125f, v1 * 0.125f);
                    } else if (cb < 768) {
                        const bool isk = cb < 640;
                        const int kc = (isk ? cb - 512 : cb - 640) + 8 * fq;
                        *(u32x4*)((isk ? Kb : Vb) + (size_t)row * 128 + kc) = pk8(v0, v1);
                        float* dst = nullptr;
                        if (!samp) { if (t >= LP - 128) dst = out + (isk ? O_NKP : O_NVP) + ((size_t)((l * 16 + b) * 128 + (t - (LP - 128)))) * 128; }
                        else dst = out + (isk ? O_NKS : O_NVS) + ((size_t)((l * 128 + b) * 128 + 120 + t)) * 128;
                        if (dst) { *(f32x4*)(dst + kc) = v0; *(f32x4*)(dst + kc + 4) = v1; }
                    } else {
                        const int uc = cb - 768 + 8 * fq;
                        *(u32x4*)(U + (size_t)row * 512 + uc) = pk8(v0, v1);
                        float* dst = nullptr;
                        if (!samp) { if (t >= LP - 15) dst = out + O_NPP + ((size_t)((l * 16 + b) * 15 + (t - (LP - 15)))) * 512; }
                        else dst = out + O_NPS + ((size_t)((l * 128 + b) * 15 + 7 + t)) * 512;
                        if (dst) { *(f32x4*)(dst + uc) = v0; *(f32x4*)(dst + uc + 4) = v1; }
                    }
                }
            }
    }
};

DEVI void unpk8(const u32x4 w, f32x4& a, f32x4& b) {
    a[0] = bf_lo(w.x); a[1] = bf_hi(w.x); a[2] = bf_lo(w.y); a[3] = bf_hi(w.y);
    b[0] = bf_lo(w.z); b[1] = bf_hi(w.z); b[2] = bf_lo(w.w); b[3] = bf_hi(w.w);
}
struct EpiRes {
    bf16_t* Hb; float* rowss;
    DEVI void operator()(const f32x4 (&acc)[2][2][4][2], const Unit& u, int wr, int wc, int fr, int fq) const {
#pragma unroll
        for (int ai = 0; ai < 2; ++ai) {
#pragma unroll
            for (int m = 0; m < 4; ++m) {
                const int row = u.pm * 256 + ai * 128 + wr * 64 + m * 16 + fr;
                float ss = 0.f;
#pragma unroll
                for (int bj = 0; bj < 2; ++bj) {
                    const size_t o = (size_t)row * DM + u.pn * 256 + bj * 128 + wc * 32 + 8 * fq;
                    f32x4 h0, h1;
                    unpk8(*(const u32x4*)(Hb + o), h0, h1);
                    h0 = h0 + acc[ai][bj][m][0]; h1 = h1 + acc[ai][bj][m][1];
                    *(u32x4*)(Hb + o) = pk8(h0, h1);
                    ss += ((h0[0] * h0[0] + h0[1] * h0[1]) + (h0[2] * h0[2] + h0[3] * h0[3])) + ((h1[0] * h1[0] + h1[1] * h1[1]) + (h1[2] * h1[2] + h1[3] * h1[3]));
                }
                ss += __shfl_xor(ss, 16);
                ss += __shfl_xor(ss, 32);
                if (fq == 0) rowss[(size_t)row * 16 + u.pn * 4 + wc] = ss;
            }
            __builtin_amdgcn_sched_barrier(0);
        }
    }
};

struct EpiUp {
    const float* rowss; bf16_t* ACT;
    DEVI void operator()(const f32x4 (&acc)[2][2][4][2], const Unit& u, int wr, int wc, int fr, int fq) const {
#pragma unroll
        for (int ai = 0; ai < 2; ++ai)
#pragma unroll
            for (int m = 0; m < 4; ++m) {
                const int row = u.pm * 256 + ai * 128 + wr * 64 + m * 16 + fr;
                const float rs = row_rs4(rowss, row, fq);
#pragma unroll
                for (int bj = 0; bj < 2; ++bj) {
                    f32x4 a0 = acc[ai][bj][m][0] * rs, a1 = acc[ai][bj][m][1] * rs;
#pragma unroll
                    for (int e = 0; e < 4; ++e) { const float x = fmaxf(a0[e], 0.f); a0[e] = x * x; const float y = fmaxf(a1[e], 0.f); a1[e] = y * y; }
                    *(u32x4*)(ACT + (size_t)row * DFF + u.pn * 256 + bj * 128 + wc * 32 + 8 * fq) = pk8(a0, a1);
                }
            }
    }
};

DEVI void transpose_tile(const float* __restrict__ W, int N, const float* __restrict__ g, bf16_t* __restrict__ Wt, int ldk, int kt, int nt_, LAS float* t, int ltid) {
    __syncthreads();
    {
        const int ty = ltid >> 4, n4 = (ltid & 15) * 4;
#pragma unroll
        for (int i = 0; i < 4; ++i) {
            const int k = ty + 16 * i;
            f32x4 v = *(const f32x4*)(W + (size_t)(kt * 64 + k) * N + nt_ * 64 + n4);
            const float s = g ? g[kt * 64 + k] : 1.f;
            t[k * 65 + n4 + 0] = v[0] * s; t[k * 65 + n4 + 1] = v[1] * s; t[k * 65 + n4 + 2] = v[2] * s; t[k * 65 + n4 + 3] = v[3] * s;
        }
    }
    __syncthreads();
    {
        const int n = ltid >> 2, kq = (ltid & 3) * 16;
        u32x4 o0, o1;
        o0.x = pk_bf16(t[(kq + 0) * 65 + n], t[(kq + 1) * 65 + n]);   o0.y = pk_bf16(t[(kq + 2) * 65 + n], t[(kq + 3) * 65 + n]);
        o0.z = pk_bf16(t[(kq + 4) * 65 + n], t[(kq + 5) * 65 + n]);   o0.w = pk_bf16(t[(kq + 6) * 65 + n], t[(kq + 7) * 65 + n]);
        o1.x = pk_bf16(t[(kq + 8) * 65 + n], t[(kq + 9) * 65 + n]);   o1.y = pk_bf16(t[(kq + 10) * 65 + n], t[(kq + 11) * 65 + n]);
        o1.z = pk_bf16(t[(kq + 12) * 65 + n], t[(kq + 13) * 65 + n]); o1.w = pk_bf16(t[(kq + 14) * 65 + n], t[(kq + 15) * 65 + n]);
        bf16_t* d = Wt + (size_t)(nt_ * 64 + n) * ldk + kt * 64 + kq;
        *(u32x4*)d = o0; *(u32x4*)(d + 8) = o1;
    }
}

DEVI bf16_t* wt_in(unsigned char* ws, int l) { return (bf16_t*)(ws + OFF_W) + (size_t)l * WL_E; }
DEVI bf16_t* wt_out(unsigned char* ws, int l) { return wt_in(ws, l) + WIN_E; }
DEVI bf16_t* wt_up(unsigned char* ws, int l) { return wt_out(ws, l) + WOUT_E; }
DEVI bf16_t* wt_dn(unsigned char* ws, int l) { return wt_up(ws, l) + WUP_E; }

constexpr int U_TRL = (320 + 128 + 1024 + 1024) / 2;
constexpr int U_TR = 2 * U_TRL;
constexpr int U_WC = U_TR + 256;
constexpr int U_ROWS = U_WC + MT / 8;
constexpr int U_ROPE = U_ROWS + (NROPE * 8 + NTHR - 1) / NTHR;
constexpr int U_CK = U_ROPE + 256;
constexpr int U_CV = U_CK + 256;
constexpr int U_CP = U_CV + 256;

DEVI void prologue(const Params& p, LAS unsigned char* lds) {
    const int tid = opaque_tid(), lane = tid & 63, wid = tid >> 6, sb = tid >> 8, ltid = tid & 255;
    bf16_t* Hb = (bf16_t*)(p.ws + OFF_HB);
    float* rowss = (float*)(p.ws + OFF_RS);
    float* rope = (float*)(p.ws + OFF_ROPE);
    LAS float* tl = (LAS float*)(lds + sb * 16640);
    for (int u = blockIdx.x; u < U_CP; u += gridDim.x) {
        if (u < U_TR) {
            const int l = u / U_TRL; int r = (u - l * U_TRL) * 2 + sb;
            if (r < 320) { transpose_tile(p.w_in + (size_t)l * DM * INW, INW, p.ln1 + l * DM, wt_in(p.ws, l), DM, r & 15, r >> 4, tl, ltid); }
            else if ((r -= 320) < 128) { transpose_tile(p.w_out + (size_t)l * DM * DM, DM, nullptr, wt_out(p.ws, l), DM, r & 7, r >> 3, tl, ltid); }
            else if ((r -= 128) < 1024) { transpose_tile(p.w_up + (size_t)l * DM * DFF, DFF, p.ln2 + l * DM, wt_up(p.ws, l), DM, r & 15, r >> 4, tl, ltid); }
            else { r -= 1024; transpose_tile(p.w_down + (size_t)l * DFF * DM, DM, nullptr, wt_dn(p.ws, l), DFF, r & 63, r >> 6, tl, ltid); }
        } else if (u < U_WC) {
            const int r = u - U_TR, l = r >> 7, g = (r >> 5) & 3, n = ((r >> 2) & 7) * 128 + (wid >> 2) * 64 + lane, c0 = (r & 3) * 32 + (wid & 3) * 8;
            const float* pw = p.pool_w + ((size_t)(l * 4 + g) * 128 + c0) * 128;
            const float* sc = p.pool_scale + l * 512 + g * 128;
            const float* wo = p.w_out + (size_t)l * DM * DM + (size_t)(512 + g * 128) * DM + n;
            float acc[8];
#pragma unroll
            for (int c = 0; c < 8; ++c) acc[c] = 0.f;
#pragma unroll 1
            for (int e0 = 0; e0 < 128; e0 += 16) {
                float w[16];
#pragma unroll
                for (int i = 0; i < 16; ++i) w[i] = wo[(size_t)(e0 + i) * DM];
#pragma unroll
                for (int i = 0; i < 16; ++i) {
                    const float ws_ = w[i] * sc[e0 + i];
#pragma unroll
                    for (int c = 0; c < 8; ++c) acc[c] += pw[c * 128 + e0 + i] * ws_;
                }
            }
            u32x4 o; o.x = pk_bf16(acc[0], acc[1]); o.y = pk_bf16(acc[2], acc[3]); o.z = pk_bf16(acc[4], acc[5]); o.w = pk_bf16(acc[6], acc[7]);
            *(u32x4*)(wt_out(p.ws, l) + (size_t)n * DM + 512 + g * 128 + c0) = o;
        } else if (u < U_ROWS) {
            const int row = (u - U_WC) * 8 + wid;
            const float* src;
            if (row < MP) { const int b = row / LP, t = row - b * LP; src = t < 16 ? p.meta + (size_t)t * DM : p.x_prompt + ((size_t)b * 2048 + (t - 16)) * DM; }
            else src = p.x_sample + (size_t)(row - MP) * DM;
            float ss = 0.f;
#pragma unroll
            for (int i = 0; i < 4; ++i) {
                const int c = i * 256 + lane * 4;
                const f32x4 v = *(const f32x4*)(src + c);
                *(u32x2*)(Hb + (size_t)row * DM + c) = pk4(v);
                ss += (v[0] * v[0] + v[1] * v[1]) + (v[2] * v[2] + v[3] * v[3]);
            }
#pragma unroll
            for (int o = 32; o >= 1; o >>= 1) ss += __shfl_xor(ss, o);
            if (lane < 16) rowss[(size_t)row * 16 + lane] = lane == 0 ? ss : 0.f;
        } else if (u < U_ROPE) {
            const int id = (u - U_ROWS) * NTHR + tid;
            if (id < NROPE * 8) {
                const int idx = id >> 3, i = id & 7;
                const int pos = idx < LP ? idx : 16384 + (idx - LP);
                const float inv = exp2f(-(float)i * 0.125f * 18.931568569324174f);
                const float ang = (float)pos * inv;
                double rev = (double)ang * 0.15915494309189535;
                rev -= rint(rev);
                const float red = (float)(rev * 6.283185307179586);
                rope[idx * 16 + i] = __cosf(red);
                rope[idx * 16 + 8 + i] = __sinf(red);
            }
        } else if (u < U_CV) {
            const bool isk = u < U_CK;
            const int r = isk ? u - U_ROPE : u - U_CK;
            const f32x4* src = (const f32x4*)((isk ? p.cache_k : p.cache_v) + (size_t)r * 128 * 128 + 8 * 128);
            f32x4* dst = (f32x4*)(p.out + (isk ? O_NKS : O_NVS) + (size_t)r * 128 * 128);
            for (int i = tid; i < 120 * 32; i += NTHR) dst[i] = src[i];
        } else {
            const int r = u - U_CV;
            const f32x4* src = (const f32x4*)(p.state_pool + (size_t)r * 15 * 512 + 8 * 512);
            f32x4* dst = (f32x4*)(p.out + O_NPS + (size_t)r * 15 * 512);
            for (int i = tid; i < 7 * 128; i += NTHR) dst[i] = src[i];
        }
    }
    __syncthreads();
}

constexpr int N_PU = NBATCH * 65;
constexpr int N_AU = N_PU + DB;

DEVI void add8(f32x4& a0, f32x4& a1, const u32x4 w) {
    a0[0] += bf_lo(w.x); a0[1] += bf_hi(w.x); a0[2] += bf_lo(w.y); a0[3] += bf_hi(w.y);
    a1[0] += bf_lo(w.z); a1[1] += bf_hi(w.z); a1[2] += bf_lo(w.w); a1[3] += bf_hi(w.w);
}

template <int W>
DEVI void pool_rows(const bf16_t* __restrict__ U, const float* __restrict__ sp, bf16_t* __restrict__ MIX, const int rowbase, const int r0, const int ch, const bool samp) {
    u32x4 x[W + 3];
#pragma unroll
    for (int k = 0; k < W + 3; ++k) {
        const int pos = r0 + 3 - k;
        x[k] = (u32x4){0u, 0u, 0u, 0u};
        if (!samp) { if (pos >= 0 && pos < LP) x[k] = *(const u32x4*)(U + (size_t)(rowbase + pos) * 512 + ch); }
        else if (pos >= 0) { if (pos < 8) x[k] = *(const u32x4*)(U + (size_t)(rowbase + pos) * 512 + ch); }
        else if (pos >= -15) { const float* s = sp + (size_t)(15 + pos) * 512 + ch; x[k] = pk8(*(const f32x4*)s, *(const f32x4*)(s + 4)); }
    }
    f32x4 s0 = {0.f, 0.f, 0.f, 0.f}, s1 = {0.f, 0.f, 0.f, 0.f};
#pragma unroll
    for (int k = 0; k < W; ++k) add8(s0, s1, x[k]);
#pragma unroll
    for (int j = 3; j >= 0; --j) {
        const int kk = 3 - j, pos = r0 + j;
        if (kk > 0) {
            f32x4 a0, a1, b0, b1;
            unpk8(x[kk + W - 1], a0, a1); unpk8(x[kk - 1], b0, b1);
            s0 = s0 + a0 - b0; s1 = s1 + a1 - b1;
        }
        const bool ok = samp ? (pos < 8) : (pos < LP);
        if (ok) {
            const int n = samp ? W : ((pos + 1) < W ? (pos + 1) : W);
            const float inv = 1.f / (float)n;
            f32x4 u0, u1;
            unpk8(x[kk], u0, u1);
            *(u32x4*)(MIX + (size_t)(rowbase + pos) * 1024 + 512 + ch) = pk8(s0 * inv - u0, s1 * inv - u1);
        }
    }
}

DEVI void mixer_phase(const Params& p, const int l, LAS unsigned char* lds_all) {
    const int tid0 = opaque_tid(), tid = tid0 & 255, kvh = tid0 >> 8, lane = tid & 63, wid = tid >> 6, fr = lane & 15, fq = lane >> 4;
    const bf16_t* Q = (const bf16_t*)(p.ws + OFF_OV + OV_Q);
    const bf16_t* Kb = (const bf16_t*)(p.ws + OFF_OV + OV_K);
    const bf16_t* Vb = (const bf16_t*)(p.ws + OFF_OV + OV_V);
    const bf16_t* U = (const bf16_t*)(p.ws + OFF_OV + OV_U);
    bf16_t* MIX = (bf16_t*)(p.ws + OFF_OV + OV_MIX);
    LAS unsigned char* Ks = lds_all + kvh * 44544;
    LAS bf16_t* Vt = (LAS bf16_t*)(Ks + 160 * 144);
    for (int unit = blockIdx.x; unit < N_AU; unit += gridDim.x) {
        const bool samp = unit >= N_PU;
        int b, t0;
        if (!samp) { b = unit / 65; t0 = (unit - b * 65) * 32; }
        else { b = unit - N_PU; t0 = 0; }
        const int rowbase = samp ? MP + b * 8 : b * LP;

        {
            const int gl = wid >> 1, g = 2 * kvh + gl, ch = kvh * 256 + ((tid & 15) + 16 * gl) * 8, r0 = t0 + 4 * ((tid >> 4) & 7);
            const float* sp = p.state_pool + (size_t)(l * 128 + (samp ? b : 0)) * 15 * 512;
            if (g == 0) pool_rows<2>(U, sp, MIX, rowbase, r0, ch, samp);
            else if (g == 1) pool_rows<4>(U, sp, MIX, rowbase, r0, ch, samp);
            else if (g == 2) pool_rows<8>(U, sp, MIX, rowbase, r0, ch, samp);
            else pool_rows<16>(U, sp, MIX, rowbase, r0, ch, samp);
        }
        __builtin_amdgcn_sched_barrier(0);
        u32x4 kq[5], vq[5];
#pragma unroll
        for (int i = 0; i < 5; ++i) {
            const int c = tid + 256 * i, j = c >> 3, dc = c & 7;
            kq[i] = (u32x4){0u, 0u, 0u, 0u}; vq[i] = kq[i];
            if (!samp) {
                const int kpos = t0 - 128 + j;
                if (kpos >= 0 && kpos < LP) {
                    const size_t o = (size_t)(rowbase + kpos) * 128 + kvh * 64 + dc * 8;
                    kq[i] = *(const u32x4*)(Kb + o); vq[i] = *(const u32x4*)(Vb + o);
                }
            } else if (j < 128) {
                const size_t o = (((size_t)(l * 128 + b) * 128 + j) * 2 + kvh) * 64 + dc * 8;
                const f32x4 k0 = *(const f32x4*)(p.cache_k + o), k1 = *(const f32x4*)(p.cache_k + o + 4);
                const f32x4 v0 = *(const f32x4*)(p.cache_v + o), v1 = *(const f32x4*)(p.cache_v + o + 4);
                kq[i] = pk8(k0, k1); vq[i] = pk8(v0, v1);
            } else if (j < 136) {
                const size_t o = (size_t)(rowbase + j - 128) * 128 + kvh * 64 + dc * 8;
                kq[i] = *(const u32x4*)(Kb + o); vq[i] = *(const u32x4*)(Vb + o);
            }
        }
        const int h = kvh * 4 + wid;
        bf16x8 qf[2][2];
#pragma unroll
        for (int qt = 0; qt < 2; ++qt) {
            const int i = qt * 16 + fr;
            const bool ok = samp ? (i < 8) : (t0 + i < LP);
            const bf16_t* qp = Q + (size_t)(rowbase + (samp ? 0 : t0) + i) * 512 + h * 64 + fq * 8;
#pragma unroll
            for (int ks = 0; ks < 2; ++ks) {
                u32x4 w = {0u, 0u, 0u, 0u};
                if (ok) w = *(const u32x4*)(qp + ks * 32);
                qf[qt][ks] = __builtin_bit_cast(bf16x8, w);
            }
        }
        __syncthreads();
#pragma unroll
        for (int i = 0; i < 5; ++i) {
            const int c = tid + 256 * i, j = c >> 3, dc = c & 7;
            *(LAS u32x4*)(Ks + j * 144 + dc * 16) = kq[i];
            LAS bf16_t* vt = Vt + (dc * 8) * 168 + j;
            vt[0 * 168] = (bf16_t)(vq[i].x & 0xffff); vt[1 * 168] = (bf16_t)(vq[i].x >> 16);
            vt[2 * 168] = (bf16_t)(vq[i].y & 0xffff); vt[3 * 168] = (bf16_t)(vq[i].y >> 16);
            vt[4 * 168] = (bf16_t)(vq[i].z & 0xffff); vt[5 * 168] = (bf16_t)(vq[i].z >> 16);
            vt[6 * 168] = (bf16_t)(vq[i].w & 0xffff); vt[7 * 168] = (bf16_t)(vq[i].w >> 16);
        }
        __syncthreads();

        f32x4 s[2][10];
#pragma unroll
        for (int t = 0; t < 10; ++t) {
            const bf16x8 k0 = *(const LAS bf16x8*)(Ks + (16 * t + fr) * 144 + fq * 16);
            const bf16x8 k1 = *(const LAS bf16x8*)(Ks + (16 * t + fr) * 144 + 64 + fq * 16);
#pragma unroll
            for (int qt = 0; qt < 2; ++qt) {
                f32x4 z = {0.f, 0.f, 0.f, 0.f};
                z = __builtin_amdgcn_mfma_f32_16x16x32_bf16(k0, qf[qt][0], z, 0, 0, 0);
                s[qt][t] = __builtin_amdgcn_mfma_f32_16x16x32_bf16(k1, qf[qt][1], z, 0, 0, 0);
            }
        }
        const float sink = p.sinks[l * 8 + h];
        float inv[2];
#pragma unroll
        for (int qt = 0; qt < 2; ++qt) {
            const int i = qt * 16 + fr;
            float mx = -INFINITY;
#pragma unroll
            for (int t = 0; t < 10; ++t)
#pragma unroll
                for (int jj = 0; jj < 4; ++jj) {
                    const int j = 16 * t + 4 * fq + jj;
                    const bool ok = (j >= i) && (j <= i + 128) && (samp || (t0 - 128 + j >= 0));
                    const float x = ok ? s[qt][t][jj] : -INFINITY;
                    s[qt][t][jj] = x;
                    mx = fmaxf(mx, x);
                }
            mx = fmaxf(mx, __shfl_xor(mx, 16));
            mx = fmaxf(mx, __shfl_xor(mx, 32));
            const float m = fmaxf(mx, sink);
            float sum = 0.f;
#pragma unroll
            for (int t = 0; t < 10; ++t)
#pragma unroll
                for (int jj = 0; jj < 4; ++jj) { const float e = __expf(s[qt][t][jj] - m); s[qt][t][jj] = e; sum += e; }
            sum += __shfl_xor(sum, 16);
            sum += __shfl_xor(sum, 32);
            inv[qt] = 1.f / (sum + __expf(sink - m));
        }
        f32x4 o[2][4];
#pragma unroll
        for (int qt = 0; qt < 2; ++qt)
#pragma unroll
            for (int dt = 0; dt < 4; ++dt) o[qt][dt] = (f32x4){0.f, 0.f, 0.f, 0.f};
#pragma unroll
        for (int pp = 0; pp < 5; ++pp) {
            bf16x8 pf[2];
#pragma unroll
            for (int qt = 0; qt < 2; ++qt) pf[qt] = __builtin_bit_cast(bf16x8, pk8(s[qt][2 * pp], s[qt][2 * pp + 1]));
#pragma unroll
            for (int dt = 0; dt < 4; ++dt) {
                const LAS bf16_t* vp = Vt + (16 * dt + fr) * 168 + 32 * pp + 4 * fq;
                const u32x2 v0 = *(const LAS u32x2*)vp, v1 = *(const LAS u32x2*)(vp + 16);
                const u32x4 vw = {v0.x, v0.y, v1.x, v1.y};
                const bf16x8 vf = __builtin_bit_cast(bf16x8, vw);
#pragma unroll
                for (int qt = 0; qt < 2; ++qt) o[qt][dt] = __builtin_amdgcn_mfma_f32_16x16x32_bf16(vf, pf[qt], o[qt][dt], 0, 0, 0);
            }
        }
#pragma unroll
        for (int qt = 0; qt < 2; ++qt) {
            const int i = qt * 16 + fr;
            const bool ok = samp ? (i < 8) : (t0 + i < LP);
            if (ok) {
                bf16_t* op = MIX + (size_t)(rowbase + (samp ? 0 : t0) + i) * 1024 + h * 64 + 4 * fq;
#pragma unroll
                for (int dt = 0; dt < 4; ++dt) *(u32x2*)(op + 16 * dt) = pk4(o[qt][dt] * inv[qt]);
            }
        }
    }
    __syncthreads();
}

DEVI void final_phase(const Params& p) {
    const int tid = opaque_tid(), lane = tid & 63, wid = tid >> 6;
    const bf16_t* Hb = (const bf16_t*)(p.ws + OFF_HB);
    const float* rowss = (const float*)(p.ws + OFF_RS);
    for (int u = blockIdx.x; u < MT / 8; u += gridDim.x) {
        const int row = u * 8 + wid;
        float* dst;
        if (row < MP) { const int b = row / LP, t = row - b * LP; if (t < 16) continue; dst = p.out + O_YP + ((size_t)b * 2048 + (t - 16)) * DM; }
        else dst = p.out + O_YS + (size_t)(row - MP) * DM;
        const float rs = row_rs(rowss, row);
#pragma unroll
        for (int i = 0; i < 2; ++i) {
            const int c = i * 512 + lane * 8;
            f32x4 v0, v1;
            unpk8(*(const u32x4*)(Hb + (size_t)row * DM + c), v0, v1);
            const f32x4 g0 = *(const f32x4*)(p.ln_f + c), g1 = *(const f32x4*)(p.ln_f + c + 4);
            *(f32x4*)(dst + c) = v0 * rs * g0; *(f32x4*)(dst + c + 4) = v1 * rs * g1;
        }
    }
}

#define XB_TMO      128
#define XB_XCNT(j)  (256  + 64 * (j))
#define XB_XSUB(j)  (1280 + 64 * (j))
#define XB_XGEN(j)  (2304 + 64 * (j))
#define XB_TOP      3328
#define XB_TOPGEN   3392
#define XCD_BAR_WORDS 3456
#define XB_SPIN_CAP (1u << 18)
DEVI unsigned xb_ld(unsigned* p)              { return __hip_atomic_load(p, __ATOMIC_RELAXED, __HIP_MEMORY_SCOPE_AGENT); }
DEVI unsigned xb_add(unsigned* p, unsigned v) { return __hip_atomic_fetch_add(p, v, __ATOMIC_RELAXED, __HIP_MEMORY_SCOPE_AGENT); }
DEVI unsigned xb_xcc_id() { return (unsigned)__builtin_amdgcn_s_getreg((3 << 11) | 20) & 0xFu; }
#define XB_SPIN(cond, bar) do { unsigned _sp = 0; while (cond) { __builtin_amdgcn_s_sleep(1); \
    if ((++_sp & 255u) == 0u) { if (xb_ld(&(bar)[XB_TMO])) break; if (_sp > XB_SPIN_CAP) { atomicAdd(&(bar)[XB_TMO], 1u); break; } } } } while (0)
struct XcdBarrier { unsigned* bar; unsigned x; volatile LAS unsigned* st; };
DEVI XcdBarrier xcd_barrier_post(unsigned* bar, volatile LAS unsigned* st) {
    XcdBarrier b; b.bar = bar; b.x = xb_xcc_id(); b.st = st;
    if (threadIdx.x == 0) (void)xb_add(&bar[XB_XCNT(b.x)], 1u);
    return b;
}
DEVI void xcd_barrier_complete(unsigned* bar, unsigned x, unsigned& nloc, unsigned& nx) {
    const unsigned G = gridDim.x * gridDim.y * gridDim.z;
    unsigned sum, cnt, mine, sp = 0u;
    for (;;) {
        sum = 0u; cnt = 0u; mine = 0u;
#pragma unroll
        for (unsigned j = 0; j < 16; ++j) { const unsigned c = xb_ld(&bar[XB_XCNT(j)]); sum += c; cnt += (c > 0u) ? 1u : 0u; mine = (j == x) ? c : mine; }
        if (sum == G) break;
        __builtin_amdgcn_s_sleep(1);
        if ((++sp & 255u) == 0u) { if (xb_ld(&bar[XB_TMO])) break; if (sp > XB_SPIN_CAP) { atomicAdd(&bar[XB_TMO], 1u); break; } }
    }
    nloc = mine > 0u ? mine : 1u; nx = cnt > 0u ? cnt : 1u;
}
DEVI void xcd_barrier(const XcdBarrier& b) {
    asm volatile("s_waitcnt vmcnt(0)" ::: "memory");
    __syncthreads();
    if (threadIdx.x == 0) {
        unsigned* bar = b.bar;
        __builtin_amdgcn_s_waitcnt(0);
        unsigned nloc = b.st[0], nx = b.st[1];
        if (nloc == 0u) { xcd_barrier_complete(bar, b.x, nloc, nx); b.st[0] = nloc; b.st[1] = nx; }
        const unsigned old = xb_add(&bar[XB_XSUB(b.x)], 1u);
        const unsigned gen = old / nloc;
        if (old + 1u == (gen + 1u) * nloc) {
            __builtin_amdgcn_fence(__ATOMIC_RELEASE, "agent");
            asm volatile("s_waitcnt vmcnt(0)" ::: "memory");
            const unsigned og = xb_add(&bar[XB_TOP], 1u);
            const unsigned tg = og / nx;
            if (og + 1u == (tg + 1u) * nx) xb_add(&bar[XB_TOPGEN], 1u);
            else XB_SPIN(xb_ld(&bar[XB_TOPGEN]) == tg, bar);
            __builtin_amdgcn_fence(__ATOMIC_ACQUIRE, "agent");
            xb_add(&bar[XB_XGEN(b.x)], 1u);
            asm volatile("s_waitcnt vmcnt(0)" ::: "memory");
        } else {
            XB_SPIN(xb_ld(&bar[XB_XGEN(b.x)]) == gen, bar);
            __builtin_amdgcn_fence(__ATOMIC_ACQUIRE, "agent");
            asm volatile("s_waitcnt vmcnt(0)" ::: "memory");
        }
    }
    __syncthreads();
}

__global__ void __launch_bounds__(NTHR, 2) hymba_fwd(Params p) {
    extern __shared__ __attribute__((aligned(16))) unsigned char lds_raw[];
    LAS unsigned char* lds = (LAS unsigned char*)lds_raw;
    cg::grid_group grid = cg::this_grid();
    bf16_t* Hb = (bf16_t*)(p.ws + OFF_HB);
    float* rowss = (float*)(p.ws + OFF_RS);
    const float* rope = (const float*)(p.ws + OFF_ROPE);
    bf16_t* Q = (bf16_t*)(p.ws + OFF_OV + OV_Q);
    bf16_t* Kb = (bf16_t*)(p.ws + OFF_OV + OV_K);
    bf16_t* Vb = (bf16_t*)(p.ws + OFF_OV + OV_V);
    bf16_t* U = (bf16_t*)(p.ws + OFF_OV + OV_U);
    bf16_t* MIX = (bf16_t*)(p.ws + OFF_OV + OV_MIX);
    bf16_t* ACT = (bf16_t*)(p.ws + OFF_OV);
    StaticOrder S;
    if (threadIdx.x < 4) ((LAS unsigned*)(lds + LDS_STAGE))[threadIdx.x] = 0u;
    __syncthreads();
    const XcdBarrier xb = xcd_barrier_post((unsigned*)(p.ws + OFF_BAR), (volatile LAS unsigned*)(lds + LDS_STAGE));

#ifndef SK_PRO
    prologue(p, lds);
#endif
#ifdef PROBE_PRO
    grid.sync();
    prologue(p, lds);
#endif
#ifdef PROBE_SYNC
    for (int i = 0; i < 10; ++i) grid.sync();
#endif
    grid.sync();
#pragma unroll 1
    for (int l = 0; l < 2; ++l) {
#ifndef SK_P1
        { EpiIn e{rowss, rope, Q, Kb, Vb, U, p.out, l}; S.init(MT, INW, gridDim.x, blockIdx.x); gemm_phase(lds, Gemm{Hb, wt_in(p.ws, l), MT, INW, DM}, S, e); }
#endif
        xcd_barrier(xb);
#ifndef SK_MIX
        mixer_phase(p, l, lds);
#endif
#ifdef PROBE_MIX
        xcd_barrier(xb);
        mixer_phase(p, l, lds);
#endif
        xcd_barrier(xb);
#ifndef SK_P3
        { EpiRes e{Hb, rowss}; S.init(MT, DM, gridDim.x, blockIdx.x); gemm_phase(lds, Gemm{MIX, wt_out(p.ws, l), MT, DM, DM}, S, e); }
#endif
        xcd_barrier(xb);
#ifndef SK_P4
        { EpiUp e{rowss, ACT}; S.init(MT, DFF, gridDim.x, blockIdx.x); gemm_phase(lds, Gemm{Hb, wt_up(p.ws, l), MT, DFF, DM}, S, e); }
#endif
        xcd_barrier(xb);
#ifndef SK_P5
        { EpiRes e{Hb, rowss}; S.init(MT, DM, gridDim.x, blockIdx.x); gemm_phase(lds, Gemm{ACT, wt_dn(p.ws, l), MT, DM, DFF}, S, e); }
#endif
        xcd_barrier(xb);
    }
    final_phase(p);
}

extern "C" void kernel_launch(void* const* d_in, const int* in_sizes, int n_in, void* d_out, int out_size, void* d_ws, size_t ws_size, hipStream_t stream) {
    if (ws_size < WS_NEED || (size_t)out_size != O_END || n_in != 16) {
        fprintf(stderr, "kernel_launch: unexpected sizes ws=%zu need=%zu out=%d need=%zu n_in=%d\n", ws_size, WS_NEED, out_size, O_END, n_in);
        return;
    }
    static int grid_blocks = 0;
    if (!grid_blocks) {
        int dev = 0, cus = 0, per_cu = 0;
        (void)hipGetDevice(&dev);
        (void)hipDeviceGetAttribute(&cus, hipDeviceAttributeMultiprocessorCount, dev);
        if (hipFuncSetAttribute((const void*)hymba_fwd, hipFuncAttributeMaxDynamicSharedMemorySize, LDS_BYTES) != hipSuccess) fprintf(stderr, "hipFuncSetAttribute failed\n");
        (void)hipOccupancyMaxActiveBlocksPerMultiprocessor(&per_cu, hymba_fwd, NTHR, LDS_BYTES);
        if (per_cu < 1) { fprintf(stderr, "occupancy query says %d\n", per_cu); per_cu = 1; }
        if (per_cu > 1) per_cu = 1;
        grid_blocks = cus * per_cu;
    }
    Params p{};
    p.x_prompt = (const float*)d_in[0]; p.x_sample = (const float*)d_in[1]; p.cache_k = (const float*)d_in[2]; p.cache_v = (const float*)d_in[3];
    p.state_pool = (const float*)d_in[4]; p.meta = (const float*)d_in[5]; p.ln1 = (const float*)d_in[6]; p.w_in = (const float*)d_in[7];
    p.sinks = (const float*)d_in[8]; p.pool_w = (const float*)d_in[9]; p.pool_scale = (const float*)d_in[10]; p.w_out = (const float*)d_in[11];
    p.ln2 = (const float*)d_in[12]; p.w_up = (const float*)d_in[13]; p.w_down = (const float*)d_in[14]; p.ln_f = (const float*)d_in[15];
    p.out = (float*)d_out; p.ws = (unsigned char*)d_ws;
    if (hipMemsetAsync((unsigned char*)d_ws + OFF_BAR, 0, BAR_BYTES, stream) != hipSuccess) fprintf(stderr, "memset failed\n");
    void* args[] = {&p};
    hipError_t e = hipLaunchCooperativeKernel((const void*)hymba_fwd, dim3(grid_blocks), dim3(NTHR), args, LDS_BYTES, stream);
    if (e != hipSuccess) fprintf(stderr, "cooperative launch failed: %s (grid %d)\n", hipGetErrorString(e), grid_blocks);
}
```
